# Optimizing an MI355X kernel written in HIP

```python
import jax, jax.numpy as jnp
from jax import lax
import numpy as np

D_MODEL = 1024
BATCH = 32
SEQ = 2048
DEPTH = 1

GRID_W = 64
CTX_LEN = 256
HEAD_DIM = 128
N_Q_HEADS = D_MODEL // HEAD_DIM
N_KV_HEADS = N_Q_HEADS // 4
Q_GROUP = N_Q_HEADS // N_KV_HEADS
ATTN_WIDTH = N_Q_HEADS * HEAD_DIM
KV_WIDTH = N_KV_HEADS * HEAD_DIM
POOL_WINDOWS = (2, 4, 8, 16)
N_POOL_GROUPS = len(POOL_WINDOWS)
POOL_WIDTH = D_MODEL // 2
POOL_GROUP_WIDTH = POOL_WIDTH // N_POOL_GROUPS
N_BRANCHES = 2
IN_WIDTH = ATTN_WIDTH + 2 * KV_WIDTH + POOL_WIDTH + N_BRANCHES * D_MODEL
SPLIT_POINTS = (ATTN_WIDTH, ATTN_WIDTH + KV_WIDTH, ATTN_WIDTH + 2 * KV_WIDTH,
                ATTN_WIDTH + 2 * KV_WIDTH + POOL_WIDTH)
D_FF = 4 * D_MODEL
Q_BLOCK = 128
ROPE_THETA = 10000.0
EPS = 1e-6
N_MOD = 6

kernel_name = "hybrid_gated_gqa_pool_dit_block"


def rms_norm(x, g):
    xf = x.astype(jnp.float32)
    y = xf * lax.rsqrt(jnp.mean(xf * xf, axis=-1, keepdims=True) + EPS)
    return (y * g.astype(jnp.float32)).astype(x.dtype)


def adaln(cond, w_mod, b_mod):
    m = jax.nn.silu(cond) @ w_mod + b_mod
    return jnp.split(m, N_MOD, axis=-1)


def modulate(h, shift, scale):
    return h * (1 + scale) + shift


def rotate_half_pairs(xp, ang):
    f = ang.shape[-1]
    x1, x2 = xp[..., :f], xp[..., f:]
    cos, sin = jnp.cos(ang), jnp.sin(ang)
    return jnp.concatenate([x1 * cos - x2 * sin, x1 * sin + x2 * cos], axis=-1)


def axial_rope(x, ang_row, ang_col):
    xf = x.astype(jnp.float32)
    half = HEAD_DIM // 2
    out = jnp.concatenate([rotate_half_pairs(xf[..., :half], ang_row),
                           rotate_half_pairs(xf[..., half:], ang_col)], axis=-1)
    return out.astype(x.dtype)


def to_heads(t, n_heads):
    b, n, _ = t.shape
    return t.reshape(b, n, n_heads, HEAD_DIM).transpose(0, 2, 1, 3)


def from_heads(t):
    b, h, n, d = t.shape
    return t.transpose(0, 2, 1, 3).reshape(b, n, h * d)


def split_projection(h, w_in, g_q, g_k):
    p = h @ w_in
    q, k, v, pool_in, gate_logits = jnp.split(p, SPLIT_POINTS, axis=-1)
    q = rms_norm(to_heads(q, N_Q_HEADS), g_q)
    k = rms_norm(to_heads(k, N_KV_HEADS), g_k)
    v = to_heads(v, N_KV_HEADS)
    return q, k, v, pool_in, gate_logits


def gqa_softmax(qg, k, v):
    s = jnp.einsum('bkgqd,bkmd->bkgqm', qg, k, preferred_element_type=jnp.float32)
    p = jax.nn.softmax(s * (HEAD_DIM ** -0.5), axis=-1)
    return jnp.einsum('bkgqm,bkmd->bkgqd', p.astype(v.dtype), v)


def latent_attention(q, k_lat, v_lat, k_ctx, v_ctx):
    b, _, n, _ = q.shape
    k_all = jnp.concatenate([k_ctx, k_lat], axis=2)
    v_all = jnp.concatenate([v_ctx, v_lat], axis=2)
    n_blk = n // Q_BLOCK
    qb = q.reshape(b, N_KV_HEADS, Q_GROUP, n_blk, Q_BLOCK, HEAD_DIM)
    qb = jnp.moveaxis(qb, 3, 0)
    o = lax.map(lambda blk: gqa_softmax(blk, k_all, v_all), qb)
    o = jnp.moveaxis(o, 0, 3).reshape(b, N_Q_HEADS, n, HEAD_DIM)
    return from_heads(o)


def context_attention(q, k, v):
    b, _, n, _ = q.shape
    qg = q.reshape(b, N_KV_HEADS, Q_GROUP, n, HEAD_DIM)
    o = gqa_softmax(qg, k, v).reshape(b, N_Q_HEADS, n, HEAD_DIM)
    return from_heads(o)


def multiscale_pool(u, w_grp, scale):
    b, n, _ = u.shape
    uf = u.astype(jnp.float32)
    cs = jnp.concatenate([jnp.zeros((b, 1, POOL_WIDTH), jnp.float32),
                          jnp.cumsum(uf, axis=1)], axis=1)
    t = jnp.arange(n)
    outs = []
    for gi, w in enumerate(POOL_WINDOWS):
        lo = jnp.clip(t - w // 2, 0, n)
        hi = jnp.clip(t + w // 2, 0, n)
        sl = slice(gi * POOL_GROUP_WIDTH, (gi + 1) * POOL_GROUP_WIDTH)
        csg = cs[..., sl]
        cnt = (hi - lo).astype(jnp.float32)[:, None]
        mean = (jnp.take(csg, hi, axis=1) - jnp.take(csg, lo, axis=1)) / cnt
        outs.append(mean - uf[..., sl])
    pooled = jnp.stack(outs, axis=2).astype(u.dtype)
    mixed = jnp.einsum('btgc,gcd->btgd', pooled, w_grp).reshape(b, n, POOL_WIDTH)
    return mixed * scale


def merge_branches(attn_o, pool_o, gate_logits, w_attn_up, w_pool_up, w_out):
    ya = attn_o @ w_attn_up
    yp = pool_o @ w_pool_up
    gates = jax.nn.sigmoid(gate_logits.astype(jnp.float32)).astype(ya.dtype)
    ga, gp = jnp.split(gates, N_BRANCHES, axis=-1)
    return (ga * ya + gp * yp) @ w_out


def sq_relu_mlp(h, w_ff1, w_ff2):
    return jnp.square(jax.nn.relu(h @ w_ff1)) @ w_ff2


def setup_inputs(seed: int = 0) -> dict:
    key = jax.random.key(seed)
    ks = jax.random.split(key, 24)
    f32 = jnp.float32

    def w(k, shape, fan_in):
        return jax.random.normal(k, shape, f32) * (fan_in ** -0.5)

    def gain(k, shape):
        return 1.0 + 0.05 * jax.random.normal(k, shape, f32)

    def bias(k, shape):
        return 0.02 * jax.random.normal(k, shape, f32)

    L = DEPTH
    return {
        "x": jax.random.normal(ks[0], (BATCH, SEQ, D_MODEL), f32),
        "c": jax.random.normal(ks[1], (BATCH, D_MODEL), f32),
        "ctx": jax.random.normal(ks[2], (BATCH, CTX_LEN, D_MODEL), f32),
        "c_ctx": jax.random.normal(ks[3], (D_MODEL,), f32),
        "w_mod": w(ks[4], (L, D_MODEL, N_MOD * D_MODEL), D_MODEL),
        "b_mod": bias(ks[5], (L, N_MOD * D_MODEL)),
        "g_pre_mix": gain(ks[6], (L, D_MODEL)),
        "g_post_mix": gain(ks[7], (L, D_MODEL)),
        "g_pre_mlp": gain(ks[8], (L, D_MODEL)),
        "g_post_mlp": gain(ks[9], (L, D_MODEL)),
        "w_in": w(ks[10], (L, D_MODEL, IN_WIDTH), D_MODEL),
        "b_gate": bias(ks[11], (L, N_BRANCHES * D_MODEL)),
        "g_q": gain(ks[12], (L, HEAD_DIM)),
        "g_k": gain(ks[13], (L, HEAD_DIM)),
        "w_attn_up": w(ks[14], (L, ATTN_WIDTH, D_MODEL), ATTN_WIDTH),
        "w_pool_grp": w(ks[15], (L, N_POOL_GROUPS, POOL_GROUP_WIDTH, POOL_GROUP_WIDTH), POOL_GROUP_WIDTH),
        "pool_scale": gain(ks[16], (L, POOL_WIDTH)),
        "w_pool_up": w(ks[17], (L, POOL_WIDTH, D_MODEL), POOL_WIDTH),
        "w_out": w(ks[18], (L, D_MODEL, D_MODEL), D_MODEL),
        "w_ff1": w(ks[19], (L, D_MODEL, D_FF), D_MODEL),
        "w_ff2": w(ks[20], (L, D_FF, D_MODEL), D_FF),
    }


def reference(x, c, ctx, c_ctx, w_mod, b_mod, g_pre_mix, g_post_mix, g_pre_mlp, g_post_mlp,
              w_in, b_gate, g_q, g_k, w_attn_up, w_pool_grp, pool_scale, w_pool_up, w_out,
              w_ff1, w_ff2):
    n_lat = x.shape[1]
    ROWS = n_lat // GRID_W
    rows = jnp.repeat(jnp.arange(ROWS), GRID_W).astype(jnp.float32)
    cols = jnp.tile(jnp.arange(GRID_W), ROWS).astype(jnp.float32)
    n_freq = HEAD_DIM // 4
    freqs = ROPE_THETA ** (-jnp.arange(n_freq, dtype=jnp.float32) / n_freq)
    ang_row = rows[:, None] * freqs
    ang_col = cols[:, None] * freqs

    for i in range(DEPTH):
        last = i == DEPTH - 1
        sh1, sc1, ga1, sh2, sc2, ga2 = [m[:, None, :] for m in adaln(c, w_mod[i], b_mod[i])]
        csh1, csc1, cga1, csh2, csc2, cga2 = adaln(c_ctx, w_mod[i], b_mod[i])

        w_in_i = w_in[i]
        h_lat = modulate(rms_norm(x, g_pre_mix[i]), sh1, sc1)
        h_ctx = modulate(rms_norm(ctx, g_pre_mix[i]), csh1, csc1)
        q_l, k_l, v_l, pool_l, gl_l = split_projection(h_lat, w_in_i, g_q[i], g_k[i])
        q_c, k_c, v_c, pool_c, gl_c = split_projection(h_ctx, w_in_i, g_q[i], g_k[i])
        gl_l = gl_l + b_gate[i]
        gl_c = gl_c + b_gate[i]
        q_l = axial_rope(q_l, ang_row, ang_col)
        k_l = axial_rope(k_l, ang_row, ang_col)

        attn_l = latent_attention(q_l, k_l, v_l, k_c, v_c)
        pooled_l = multiscale_pool(pool_l, w_pool_grp[i], pool_scale[i])
        y_l = merge_branches(attn_l, pooled_l, gl_l, w_attn_up[i], w_pool_up[i], w_out[i])
        x = x + ga1 * rms_norm(y_l, g_post_mix[i])

        if not last:
            attn_c = context_attention(q_c, k_c, v_c)
            pooled_c = multiscale_pool(pool_c, w_pool_grp[i], pool_scale[i])
            y_c = merge_branches(attn_c, pooled_c, gl_c, w_attn_up[i], w_pool_up[i], w_out[i])
            ctx = ctx + cga1 * rms_norm(y_c, g_post_mix[i])

        h2 = modulate(rms_norm(x, g_pre_mlp[i]), sh2, sc2)
        x = x + ga2 * rms_norm(sq_relu_mlp(h2, w_ff1[i], w_ff2[i]), g_post_mlp[i])
        if not last:
            h2c = modulate(rms_norm(ctx, g_pre_mlp[i]), csh2, csc2)
            ctx = ctx + cga2 * rms_norm(sq_relu_mlp(h2c, w_ff1[i], w_ff2[i]), g_post_mlp[i])

    return x
```

```cpp
#include <hip/hip_runtime.h>
#include <hip/hip_cooperative_groups.h>
#include <hip/hip_bf16.h>
#include <cstdio>
#include <cstdint>
#include <cmath>
namespace cg = cooperative_groups;
namespace pg8 {
#define PG8_LAS __attribute__((address_space(3)))
typedef unsigned short bf16_t;
typedef short bf16x8 __attribute__((ext_vector_type(8)));
typedef float f32x4 __attribute__((ext_vector_type(4)));
typedef unsigned u32x4 __attribute__((ext_vector_type(4)));
constexpr int BM = 256, BK = 64, HALF = 128, HTB = HALF * BK * 2  , STAGE_BYTES = 8 * HTB, NXCD = 8, WGM = 8;

__host__ __device__ __forceinline__ int lds_byte(int r, int c) { const int st = (r >> 4) * 2 + (c >> 5), rr = r & 15, cc = c & 31, ob = rr * 64 + cc * 2; return st * 1024 + (ob ^ (((ob >> 9) & 1) << 5)); }
__host__ __device__ __forceinline__ void stage_rc(int b, int& R, int& C) { const int st = b / 1024, sb = b % 1024, swz = sb ^ (((sb >> 9) & 1) << 5); R = (st >> 1) * 16 + swz / 64; C = (st & 1) * 32 + (swz % 64) / 2; }
__host__ __device__ __forceinline__ int perm32(int rho) { const int n = rho >> 4, i = rho & 15; return 8 * (i >> 2) + 4 * n + (i & 3); }

struct Unit { int pm, pn; };
struct Gemm { const bf16_t* A; const bf16_t* Bt; int M, N, K; };

struct StaticOrder {
    int nM, nN, nwg, G, c;
    __host__ __device__ void init(int M, int N, int G_, int c_) { nM = M / BM; nN = N / BM; nwg = nM * nN; G = G_; c = c_; }
    __host__ __device__ bool next(int i, Unit& u) const {
        const long L = (long)i * G + c; if (L >= nwg) return false;
        int wgid = (int)L; { const int q = nwg / NXCD, r = nwg % NXCD, xcd = wgid % NXCD, off = wgid / NXCD; wgid = (xcd < r ? xcd * (q + 1) : r * (q + 1) + (xcd - r) * q) + off; }
        const int nig = WGM * nN, gid = wgid / nig, fm = gid * WGM, gsz = (nM - fm) < WGM ? (nM - fm) : WGM;
        u.pm = fm + ((wgid % nig) % gsz); u.pn = (wgid % nig) / gsz; return true;
    }
    __device__ __forceinline__ void a_ready(const Unit&) const {}
    __device__ __forceinline__ void done(const Unit&) const {}
};

__device__ __forceinline__ unsigned cvt_pk_bf16(float lo, float hi) { unsigned r; asm volatile("v_cvt_pk_bf16_f32 %0, %1, %2" : "=v"(r) : "v"(lo), "v"(hi)); return r; }
typedef float f32x2 __attribute__((ext_vector_type(2)));
__device__ __forceinline__ float bf_lo(unsigned u) { return __uint_as_float(u << 16); }
__device__ __forceinline__ float bf_hi(unsigned u) { return __uint_as_float(u & 0xffff0000u); }
__device__ __forceinline__ float sigmoidf_fast(float x) { return __builtin_amdgcn_rcpf(1.0f + __expf(-x)); }
typedef unsigned u32x2 __attribute__((ext_vector_type(2)));
constexpr int KVROWS = 2304;

struct EpiInproj {
    static constexpr bool PERM = true, AFTER_DRAIN = false;
    bf16_t *Q, *Kb, *Vb, *PI, *GT; const float *gq, *gk, *bgate, *cosT, *sinT; PG8_LAS float* exch;
    __device__ __forceinline__ void operator()(const f32x4 (&acc)[2][2][4][2], const Unit& u, int wr, int wc, int fr, int fq) const {
        const int pn = u.pn, pm = u.pm;
        const bool isctx = pm >= 256;
        const int rl0 = wr * 64 + fr;
        const int kvbase = isctx ? (pm - 256) * KVROWS : (pm >> 3) * KVROWS + 256 + (pm & 7) * 256;
        if (pn < 5) {
#pragma unroll
            for (int ai = 0; ai < 2; ++ai)
#pragma unroll
                for (int m = 0; m < 4; ++m)
#pragma unroll
                    for (int bj = 0; bj < 2; ++bj) {
                        const f32x4 a = acc[ai][bj][m][0], b = acc[ai][bj][m][1];
                        float s = (a[0] * a[0] + a[1] * a[1]) + (a[2] * a[2] + a[3] * a[3]) + (b[0] * b[0] + b[1] * b[1]) + (b[2] * b[2] + b[3] * b[3]);
                        s += __shfl_xor(s, 16); s += __shfl_xor(s, 32);
                        if (fq == 0) exch[((ai * HALF + rl0 + m * 16) * 2 + bj) * 4 + wc] = s;
                    }
            asm volatile("s_waitcnt lgkmcnt(0)" ::: "memory"); __builtin_amdgcn_s_barrier(); asm volatile("" ::: "memory");
            const int hh = wc >> 1, j0 = 16 * (wc & 1) + 4 * fq;
            const float* gain = (pn < 4) ? gq : gk;
            const f32x4 g1 = *(const f32x4*)(gain + 64 * hh + j0), g2 = *(const f32x4*)(gain + 64 * hh + 32 + j0);
#pragma unroll
            for (int ai = 0; ai < 2; ++ai)
#pragma unroll
                for (int m = 0; m < 4; ++m) {
                    const int rl = ai * HALF + rl0 + m * 16;
                    const int t = (pm & 7) * 256 + rl;
                    const int pos = hh == 0 ? (t >> 6) : (t & 63);
                    f32x4 c4 = (f32x4){1.f, 1.f, 1.f, 1.f}, s4 = (f32x4){0.f, 0.f, 0.f, 0.f};
                    if (!isctx) { c4 = *(const f32x4*)(cosT + pos * 32 + j0); s4 = *(const f32x4*)(sinT + pos * 32 + j0); }
#pragma unroll
                    for (int bj = 0; bj < 2; ++bj) {
                        const f32x4 p4 = *(const PG8_LAS f32x4*)(exch + (rl * 2 + bj) * 4);
                        const float rstd = rsqrtf(((p4[0] + p4[1]) + (p4[2] + p4[3])) * (1.0f / 128.0f) + 1e-6f);
                        const f32x4 x1 = acc[ai][bj][m][0] * rstd * g1, x2 = acc[ai][bj][m][1] * rstd * g2;
                        const f32x4 o1 = x1 * c4 - x2 * s4, o2 = x1 * s4 + x2 * c4;
                        bf16_t* dst = (pn < 4) ? Q + (size_t)(pm * BM + rl) * 1024 + (2 * pn + bj) * 128 + 64 * hh + j0
                                               : Kb + (size_t)(kvbase + rl) * 256 + bj * 128 + 64 * hh + j0;
                        u32x2 w1, w2; w1.x = cvt_pk_bf16(o1[0], o1[1]); w1.y = cvt_pk_bf16(o1[2], o1[3]); w2.x = cvt_pk_bf16(o2[0], o2[1]); w2.y = cvt_pk_bf16(o2[2], o2[3]);
                        *(u32x2*)dst = w1; *(u32x2*)(dst + 32) = w2;
                    }
                }
        } else {
            const int ct0 = wc * 32 + 8 * fq;
#pragma unroll
            for (int ai = 0; ai < 2; ++ai)
#pragma unroll
                for (int m = 0; m < 4; ++m) {
                    const int rl = ai * HALF + rl0 + m * 16;
#pragma unroll
                    for (int bj = 0; bj < 2; ++bj) {
                        const int col = bj * HALF + ct0;
                        f32x4 v0 = acc[ai][bj][m][0], v1 = acc[ai][bj][m][1];
                        bf16_t* dst;
                        if (pn == 5) dst = Vb + (size_t)(kvbase + rl) * 256 + col;
                        else if (pn < 8) dst = PI + (size_t)(pm * BM + rl) * 512 + (pn - 6) * 256 + col;
                        else {
                            const int gcol = (pn - 8) * 256 + col;
                            const f32x4 b0 = *(const f32x4*)(bgate + gcol), b1 = *(const f32x4*)(bgate + gcol + 4);
                            v0 += b0; v1 += b1;
#pragma unroll
                            for (int e = 0; e < 4; ++e) { v0[e] = sigmoidf_fast(v0[e]); v1[e] = sigmoidf_fast(v1[e]); }
                            dst = GT + (size_t)(pm * BM + rl) * 2048 + gcol;
                        }
                        u32x4 w; w.x = cvt_pk_bf16(v0[0], v0[1]); w.y = cvt_pk_bf16(v0[2], v0[3]); w.z = cvt_pk_bf16(v1[0], v1[1]); w.w = cvt_pk_bf16(v1[2], v1[3]);
                        *(u32x4*)dst = w;
                    }
                }
        }
    }
};
struct InprojOrder {
    StaticOrder so;
    __device__ void init(int G_, int c_) { so.init(65536, 4096, G_, c_); }
    __device__ bool next(int i, Unit& u) const {
        const long L = (long)i * so.G + so.c;
        if (L < so.nwg) return so.next(i, u);
        const int j = (int)(L - so.nwg); if (j >= 64) return false;
        u.pm = 256 + (j >> 1); u.pn = 4 + (j & 1); return true;
    }
    __device__ __forceinline__ void a_ready(const Unit&) const {}
    __device__ __forceinline__ void done(const Unit&) const {}
};
template <int MODE> struct EpiGen {
    static constexpr bool PERM = true, AFTER_DRAIN = false;
    bf16_t* O; int ldc; const float* scale; const bf16_t* GT; int goff; const bf16_t* T;
    __device__ __forceinline__ void operator()(const f32x4 (&acc)[2][2][4][2], const Unit& u, int wr, int wc, int fr, int fq) const {
        const int row0 = u.pm * BM + wr * 64 + fr, col0 = u.pn * BM + wc * 32 + 8 * fq;
#pragma unroll
        for (int ai = 0; ai < 2; ++ai)
#pragma unroll
            for (int m = 0; m < 4; ++m) {
                const size_t row = (size_t)(row0 + ai * HALF + m * 16);
#pragma unroll
                for (int bj = 0; bj < 2; ++bj) {
                    const int col = col0 + bj * HALF;
                    f32x4 v0 = acc[ai][bj][m][0], v1 = acc[ai][bj][m][1];
                    if (MODE == 0) { v0 *= *(const f32x4*)(scale + col); v1 *= *(const f32x4*)(scale + col + 4); }
                    if (MODE == 1 || MODE == 2) {
                        const u32x4 g = *(const u32x4*)(GT + row * 2048 + goff + col);
                        v0 *= (f32x4){bf_lo(g.x), bf_hi(g.x), bf_lo(g.y), bf_hi(g.y)}; v1 *= (f32x4){bf_lo(g.z), bf_hi(g.z), bf_lo(g.w), bf_hi(g.w)};
                    }
                    if (MODE == 2) {
                        const u32x4 t = *(const u32x4*)(T + row * ldc + col);
                        v0 += (f32x4){bf_lo(t.x), bf_hi(t.x), bf_lo(t.y), bf_hi(t.y)}; v1 += (f32x4){bf_lo(t.z), bf_hi(t.z), bf_lo(t.w), bf_hi(t.w)};
                    }
                    if (MODE == 3) {
#pragma unroll
                        for (int e = 0; e < 4; ++e) { const float a = fmaxf(v0[e], 0.f), b = fmaxf(v1[e], 0.f); v0[e] = a * a; v1[e] = b * b; }
                    }
                    u32x4 w; w.x = cvt_pk_bf16(v0[0], v0[1]); w.y = cvt_pk_bf16(v0[2], v0[3]); w.z = cvt_pk_bf16(v1[0], v1[1]); w.w = cvt_pk_bf16(v1[2], v1[3]);
                    *(u32x4*)(O + row * ldc + col) = w;
                }
            }
    }
};
struct EpiF32 {
    static constexpr bool PERM = false, AFTER_DRAIN = false;
    float* O; int ldc;
    __device__ __forceinline__ void operator()(const f32x4 (&acc)[2][2][4][2], const Unit& u, int wr, int wc, int fr, int fq) const {
        const int row0 = u.pm * BM + wr * 64 + fr, col0 = u.pn * BM + wc * 32 + 4 * fq;
#pragma unroll
        for (int ai = 0; ai < 2; ++ai)
#pragma unroll
            for (int m = 0; m < 4; ++m) {
                float* rp = O + (size_t)(row0 + ai * HALF + m * 16) * ldc + col0;
#pragma unroll
                for (int bj = 0; bj < 2; ++bj)
#pragma unroll
                    for (int n = 0; n < 2; ++n) *(f32x4*)(rp + bj * HALF + n * 16) = acc[ai][bj][m][n];
            }
    }
};

template <class Epi, class Sched, bool ALIGN_EPI = false, bool SP2 = false>
__device__ __forceinline__ void gemm_phase(PG8_LAS unsigned char* lds, const Gemm g, const Sched& S, const Epi& E) {
    const int tid = threadIdx.x, wid = __builtin_amdgcn_readfirstlane(tid >> 6), lane = tid & 63, wr = wid >> 2, wc = wid & 3, fr = lane & 15, fq = lane >> 4;
    const int K = g.K, nt = K / BK;
    unsigned voffA[2], voffB[2];
#pragma unroll
    for (int i = 0; i < 2; ++i) { int R, C; stage_rc(tid * 16 + i * 8192, R, C); const int Rb = Epi::PERM ? ((R & ~31) + perm32(R & 31)) : R;
        voffA[i] = (unsigned)(R * K + C) * 2u; voffB[i] = (unsigned)(Rb * K + C) * 2u; }
    const size_t kstep = (size_t)(BK * 2);
    const size_t hstep = (size_t)HALF * K * 2;
    const size_t tstep = 2 * hstep;
    const unsigned ldsw = (unsigned)wid * 1024u;
    const int aoff = lds_byte(wr * 64 + fr, fq * 8), boff = lds_byte(wc * 32 + fr, fq * 8);
#define PG8_SA(b, h) (((b) * 2 + (h)) * HTB)
#define PG8_SB(b, h) ((4 + (b) * 2 + (h)) * HTB)
#define PG8_STAGE(bufoff, gbase, voff) do { _Pragma("unroll") for (int _i = 0; _i < 2; ++_i) \
        __builtin_amdgcn_global_load_lds((const unsigned*)((const char*)(gbase) + (voff)[_i]), (PG8_LAS unsigned*)(lds + (bufoff) + ldsw + _i * 8192), 16, 0, 0); } while (0)
#define PG8_LDA(dst, b, h) do { _Pragma("unroll") for (int m = 0; m < 4; ++m) _Pragma("unroll") for (int k = 0; k < 2; ++k) dst[m][k] = *(const PG8_LAS bf16x8*)(lds + PG8_SA(b, h) + aoff + m * 2048 + k * 1024); } while (0)
#define PG8_LDB(dst, b, h) do { _Pragma("unroll") for (int n = 0; n < 2; ++n) _Pragma("unroll") for (int k = 0; k < 2; ++k) dst[n][k] = *(const PG8_LAS bf16x8*)(lds + PG8_SB(b, h) + boff + n * 2048 + k * 1024); } while (0)
#define PG8_MMA(ai, bj, At, Bt) do { __builtin_amdgcn_s_setprio(1); _Pragma("unroll") for (int m = 0; m < 4; ++m) _Pragma("unroll") for (int n = 0; n < 2; ++n) _Pragma("unroll") for (int k = 0; k < 2; ++k) \
        acc[ai][bj][m][n] = __builtin_amdgcn_mfma_f32_16x16x32_bf16(Bt[n][k], At[m][k], acc[ai][bj][m][n], 0, 0, 0); __builtin_amdgcn_s_setprio(0); } while (0)
#define PG8_WAIT_V(n) asm volatile("s_waitcnt vmcnt(" #n ")" ::: "memory")
#define PG8_WAIT_L(n) asm volatile("s_waitcnt lgkmcnt(" #n ")" ::: "memory")
#define PG8_BAR __builtin_amdgcn_s_barrier()
#define PG8_SCHED __builtin_amdgcn_sched_barrier(0)
    Unit cur, nxt; int ui = 0;
    if (!S.next(0, cur)) return;
    f32x4 acc[2][2][4][2];
#pragma unroll
    for (int a = 0; a < 2; ++a)
#pragma unroll
        for (int b = 0; b < 2; ++b)
#pragma unroll
            for (int m = 0; m < 4; ++m)
#pragma unroll
                for (int n = 0; n < 2; ++n) acc[a][b][m][n] = (f32x4){0.f, 0.f, 0.f, 0.f};
    bf16x8 At[4][2], B0[2][2], B1[2][2];
    const char* cA = (const char*)g.A + (size_t)cur.pm * tstep; const char* cB = (const char*)g.Bt + (size_t)cur.pn * tstep;
    S.a_ready(cur);
    if constexpr (SP2) {
        PG8_STAGE(PG8_SB(0, 0), cB, voffB); PG8_STAGE(PG8_SB(0, 1), cB + hstep, voffB); PG8_STAGE(PG8_SA(0, 0), cA, voffA); PG8_STAGE(PG8_SA(0, 1), cA + hstep, voffA);
        if (wr == 1) PG8_BAR;
        PG8_WAIT_V(2); PG8_BAR;
        PG8_STAGE(PG8_SB(1, 0), cB + kstep, voffB); PG8_STAGE(PG8_SA(1, 0), cA + kstep, voffA); PG8_STAGE(PG8_SB(1, 1), cB + hstep + kstep, voffB);
        PG8_WAIT_V(6); PG8_BAR;
    } else {
        PG8_STAGE(PG8_SB(0, 0), cB, voffB); PG8_STAGE(PG8_SA(0, 0), cA, voffA); PG8_STAGE(PG8_SB(0, 1), cB + hstep, voffB); PG8_STAGE(PG8_SA(0, 1), cA + hstep, voffA);
        if (wr == 1) PG8_BAR;
        PG8_WAIT_V(4); PG8_BAR;
        PG8_STAGE(PG8_SB(1, 0), cB + kstep, voffB); PG8_STAGE(PG8_SA(1, 0), cA + kstep, voffA); PG8_STAGE(PG8_SB(1, 1), cB + hstep + kstep, voffB);
        PG8_WAIT_V(6); PG8_BAR;
    }
    for (;;) {
        const bool has_next = S.next(ui + 1, nxt);
        const char* nA = has_next ? (const char*)g.A + (size_t)nxt.pm * tstep : cA; const char* nB = has_next ? (const char*)g.Bt + (size_t)nxt.pn * tstep : cB;
        for (int t = 0; t < nt; t += 2) {
            const bool last = (t == nt - 2);
            const char* a1 = cA + (size_t)(t + 1) * kstep;
            const char* a2 = last ? nA : cA + (size_t)(t + 2) * kstep; const char* b2 = last ? nB : cB + (size_t)(t + 2) * kstep;
            const char* a3 = a2 + kstep; const char* b3 = b2 + kstep;
            if (last && has_next) S.a_ready(nxt);
            if constexpr (SP2) {
            PG8_LDB(B0, 0, 0); PG8_LDB(B1, 0, 1); PG8_SCHED; PG8_LDA(At, 0, 0); PG8_STAGE(PG8_SA(1, 1), a1 + hstep, voffA);
            PG8_WAIT_V(8); PG8_WAIT_L(0); PG8_BAR; PG8_MMA(0, 0, At, B0); PG8_MMA(0, 1, At, B1); PG8_BAR; PG8_SCHED;
            PG8_LDA(At, 0, 1); PG8_STAGE(PG8_SB(0, 0), b2, voffB); PG8_STAGE(PG8_SB(0, 1), b2 + hstep, voffB); PG8_STAGE(PG8_SA(0, 0), a2, voffA);
            PG8_WAIT_V(8); PG8_WAIT_L(0); PG8_BAR; PG8_MMA(1, 0, At, B0); PG8_MMA(1, 1, At, B1); PG8_BAR; PG8_SCHED;
            PG8_LDB(B0, 1, 0); PG8_LDB(B1, 1, 1); PG8_SCHED; PG8_LDA(At, 1, 0); PG8_STAGE(PG8_SA(0, 1), a2 + hstep, voffA);
            PG8_WAIT_V(8); PG8_WAIT_L(0); PG8_BAR; PG8_MMA(0, 0, At, B0); PG8_MMA(0, 1, At, B1); PG8_BAR; PG8_SCHED;
            PG8_LDA(At, 1, 1); PG8_STAGE(PG8_SB(1, 0), b3, voffB); PG8_STAGE(PG8_SB(1, 1), b3 + hstep, voffB); PG8_STAGE(PG8_SA(1, 0), a3, voffA);
            PG8_WAIT_V(8); PG8_WAIT_L(0); PG8_BAR; PG8_MMA(1, 0, At, B0); PG8_MMA(1, 1, At, B1); PG8_BAR; PG8_SCHED;
            } else {
            PG8_LDB(B0, 0, 0); PG8_SCHED; PG8_LDA(At, 0, 0); PG8_STAGE(PG8_SA(1, 1), a1 + hstep, voffA);
            PG8_WAIT_L(8); PG8_BAR; PG8_WAIT_L(0); PG8_MMA(0, 0, At, B0); PG8_BAR; PG8_SCHED;
            PG8_LDB(B1, 0, 1); PG8_STAGE(PG8_SB(0, 0), b2, voffB);
            PG8_BAR; PG8_WAIT_L(0); PG8_MMA(0, 1, At, B1); PG8_BAR;
            PG8_LDA(At, 0, 1); PG8_STAGE(PG8_SA(0, 0), a2, voffA);
            PG8_BAR; PG8_WAIT_L(0); PG8_MMA(1, 0, At, B0); PG8_BAR; PG8_SCHED;
            PG8_STAGE(PG8_SB(0, 1), b2 + hstep, voffB);
            PG8_WAIT_V(6); PG8_BAR; PG8_MMA(1, 1, At, B1); PG8_BAR;
            PG8_LDB(B0, 1, 0); PG8_SCHED; PG8_LDA(At, 1, 0); PG8_STAGE(PG8_SA(0, 1), a2 + hstep, voffA);
            PG8_WAIT_L(8); PG8_BAR; PG8_WAIT_L(0); PG8_MMA(0, 0, At, B0); PG8_BAR; PG8_SCHED;
            PG8_LDB(B1, 1, 1); PG8_STAGE(PG8_SB(1, 0), b3, voffB);
            PG8_BAR; PG8_WAIT_L(0); PG8_MMA(0, 1, At, B1); PG8_BAR;
            PG8_LDA(At, 1, 1); PG8_STAGE(PG8_SA(1, 0), a3, voffA);
            PG8_BAR; PG8_WAIT_L(0); PG8_MMA(1, 0, At, B0); PG8_BAR; PG8_SCHED;
            PG8_STAGE(PG8_SB(1, 1), b3 + hstep, voffB);
            PG8_WAIT_V(6); PG8_BAR; PG8_MMA(1, 1, At, B1); PG8_BAR;
            }
        }
        if constexpr (ALIGN_EPI) { if (wr == 0) PG8_BAR; }
        if constexpr (!Epi::AFTER_DRAIN) { E(acc, cur, wr, wc, fr, fq); S.done(cur); }
        if (!has_next) break;
#pragma unroll
        for (int a = 0; a < 2; ++a)
#pragma unroll
            for (int b = 0; b < 2; ++b)
#pragma unroll
                for (int m = 0; m < 4; ++m)
#pragma unroll
                    for (int n = 0; n < 2; ++n) acc[a][b][m][n] = (f32x4){0.f, 0.f, 0.f, 0.f};
        cur = nxt; cA = nA; cB = nB; ++ui;
        if constexpr (ALIGN_EPI) { if (wr == 1) PG8_BAR; }
    }
    PG8_WAIT_V(0);
    if constexpr (!ALIGN_EPI) { if (wr == 0) PG8_BAR; }
    PG8_BAR;
    if constexpr (Epi::AFTER_DRAIN) { E.fused(acc, cur, wr, wc, fr, fq, lds, wid, lane); S.done(cur); }
#undef PG8_SA
#undef PG8_SB
#undef PG8_STAGE
#undef PG8_LDA
#undef PG8_LDB
#undef PG8_MMA
#undef PG8_WAIT_V
#undef PG8_WAIT_L
#undef PG8_BAR
#undef PG8_SCHED
}
}
namespace attn {
using bf16 = __hip_bfloat16;
constexpr int   D = 128, NW = 8, QBLK = 32, KVBLK = 64;
constexpr float SCALE = 0.088388347648318440f;
constexpr float THR = 8.f;
constexpr int SDEPTH = 2;
constexpr int LDQ = 1024, LDK = 256, LDO = 1024;
constexpr size_t SHM_V = KVBLK * D * 2, SHM_K = KVBLK * D * 2, SHM_ATTN = 2 * SHM_V + 2 * SHM_K + NW * 64 * 4;
using bf16x8 = __attribute__((ext_vector_type(8))) short;
using s16x4  = __attribute__((ext_vector_type(4))) short;
using f32x16 = __attribute__((ext_vector_type(16))) float;
using f32x8  = __attribute__((ext_vector_type(8))) float;
using u32x4  = __attribute__((ext_vector_type(4))) unsigned;
#define KSWZ(row, colB) ((row) * 256 + ((colB) ^ (((row) & 7) << 4)))
#define SBAR() __builtin_amdgcn_sched_barrier(0)
__device__ __forceinline__ int crow(int r, int hi) { return (r & 3) + 8 * (r >> 2) + 4 * hi; }
__device__ __forceinline__ unsigned cvtpk(float lo, float hi) {
  unsigned r; asm volatile("v_cvt_pk_bf16_f32 %0, %1, %2" : "=v"(r) : "v"(lo), "v"(hi)); return r;
}
template <typename TIn> struct Stage;
template <> struct Stage<bf16>  { using T = bf16x8;
  __device__ static __forceinline__ T ld8(const bf16* p) { return *reinterpret_cast<const bf16x8*>(p); }
  __device__ static __forceinline__ bf16x8 tobf(T x) { return x; } };
template <> struct Stage<float> { using T = f32x8;
  __device__ static __forceinline__ T ld8(const float* p) { return *reinterpret_cast<const f32x8*>(p); }
  __device__ static __forceinline__ bf16x8 tobf(T x) {
    u32x4 w = {cvtpk(x[0], x[1]), cvtpk(x[2], x[3]), cvtpk(x[4], x[5]), cvtpk(x[6], x[7])}; return *reinterpret_cast<bf16x8*>(&w); } };

__device__ __forceinline__ void partialSM(f32x16& p0, f32x16& p1, float& m_reg, float& mn, float& alpha) {
  constexpr float C = SCALE * 1.4426950408889634f;
  float pmax = p0[0]; for (int r = 1; r < 16; ++r) pmax = fmaxf(pmax, p0[r]); for (int r = 0; r < 16; ++r) pmax = fmaxf(pmax, p1[r]);
  { auto rr = __builtin_amdgcn_permlane32_swap(__float_as_uint(pmax), __float_as_uint(pmax), false, false);
    pmax = fmaxf(__uint_as_float(rr[0]), __uint_as_float(rr[1])); }
  if (__builtin_expect(__all(pmax - m_reg <= THR / SCALE), 1)) { mn = m_reg; alpha = 1.f; }
  else { mn = fmaxf(m_reg, pmax); alpha = __builtin_amdgcn_exp2f((m_reg - mn) * C); m_reg = mn; }
  float mnC = -mn * C;
  for (int r = 0; r < 16; ++r) p0[r] = fmaf(p0[r], C, mnC); for (int r = 0; r < 16; ++r) p1[r] = fmaf(p1[r], C, mnC);
  for (int r = 0; r < 16; ++r) p0[r] = __builtin_amdgcn_exp2f(p0[r]);
}
__device__ __forceinline__ void finishSM(f32x16& p0, f32x16& p1, float alpha, float& l_reg, bf16x8& pa0, bf16x8& pa1, bf16x8& pa2, bf16x8& pa3) {
  for (int r = 0; r < 16; ++r) p1[r] = __builtin_amdgcn_exp2f(p1[r]);
  float ps = 0; for (int r = 0; r < 16; ++r) ps += p0[r]; for (int r = 0; r < 16; ++r) ps += p1[r];
  { auto rr = __builtin_amdgcn_permlane32_swap(__float_as_uint(ps), __float_as_uint(ps), false, false);
    ps = __uint_as_float(rr[0]) + __uint_as_float(rr[1]); }
  l_reg = l_reg * alpha + ps;
#define PK4(P, BASE, OUT) do { unsigned a0 = cvtpk(P[BASE + 0], P[BASE + 1]), a1 = cvtpk(P[BASE + 2], P[BASE + 3]);   \
    unsigned b0 = cvtpk(P[BASE + 4], P[BASE + 5]), b1 = cvtpk(P[BASE + 6], P[BASE + 7]);                              \
    auto r0 = __builtin_amdgcn_permlane32_swap(a0, b0, false, false); auto r1 = __builtin_amdgcn_permlane32_swap(a1, b1, false, false); \
    u32x4 w = {r0[0], r1[0], r0[1], r1[1]}; OUT = *reinterpret_cast<bf16x8*>(&w); } while (0)
  PK4(p0, 0, pa0); PK4(p0, 8, pa1); PK4(p1, 0, pa2); PK4(p1, 8, pa3);
#undef PK4
}
__device__ __forceinline__ void qkt(f32x16& p0, f32x16& p1, const bf16* Ks, const bf16x8* qr, int r32, int hi) {
  p0 = f32x16{}; p1 = f32x16{};
  for (int d0 = 0; d0 < 8; ++d0) { int cb = (d0 * 16 + hi * 8) * 2;
    bf16x8 b0 = *reinterpret_cast<const bf16x8*>((const char*)Ks + KSWZ(r32, cb));
    bf16x8 b1 = *reinterpret_cast<const bf16x8*>((const char*)Ks + KSWZ(32 + r32, cb));
    p0 = __builtin_amdgcn_mfma_f32_32x32x16_bf16(b0, qr[d0], p0, 0, 0, 0);
    p1 = __builtin_amdgcn_mfma_f32_32x32x16_bf16(b1, qr[d0], p1, 0, 0, 0); }
}
__device__ __forceinline__ int v_st(int k, int c) { const int kk = (k & ~0xC) | ((k & 4) << 1) | ((k & 8) >> 1); return ((kk >> 3) * 4 + (c >> 5)) * 512 + ((kk & 7) * 32 + (c & 31)) * 2; }
__device__ __forceinline__ int v_rd_base(int lane) { return ((lane & 3) << 3) | (((lane >> 2) & 3) << 6) | (((lane >> 4) & 1) << 5) | (((lane >> 5) & 1) << 8); }
constexpr int v_rd_off(int d0, int ks, int half) { return d0 * 512 + ks * 4096 + half * 2048; }
template <int OFF> __device__ __forceinline__ s16x4 tr_read(int vb) {
  s16x4 r; asm volatile("ds_read_b64_tr_b16 %0, %1 offset:%2" : "=&v"(r) : "v"(vb), "i"(OFF) : "memory"); return r;
}
template <int D0> __device__ __forceinline__ void pv_one(f32x16& od, int vb, bf16x8 pa0, bf16x8 pa1, bf16x8 pa2, bf16x8 pa3) {
  const s16x4 l0 = tr_read<v_rd_off(D0, 0, 0)>(vb), h0 = tr_read<v_rd_off(D0, 0, 1)>(vb), l1 = tr_read<v_rd_off(D0, 1, 0)>(vb), h1 = tr_read<v_rd_off(D0, 1, 1)>(vb);
  const s16x4 l2 = tr_read<v_rd_off(D0, 2, 0)>(vb), h2 = tr_read<v_rd_off(D0, 2, 1)>(vb), l3 = tr_read<v_rd_off(D0, 3, 0)>(vb), h3 = tr_read<v_rd_off(D0, 3, 1)>(vb);
  asm volatile("s_waitcnt lgkmcnt(0)" ::: "memory"); SBAR();
#define PK(L, H) (bf16x8){L[0], L[1], L[2], L[3], H[0], H[1], H[2], H[3]}
  od = __builtin_amdgcn_mfma_f32_32x32x16_bf16(pa0, PK(l0, h0), od, 0, 0, 0);
  od = __builtin_amdgcn_mfma_f32_32x32x16_bf16(pa1, PK(l1, h1), od, 0, 0, 0);
  od = __builtin_amdgcn_mfma_f32_32x32x16_bf16(pa2, PK(l2, h2), od, 0, 0, 0);
  od = __builtin_amdgcn_mfma_f32_32x32x16_bf16(pa3, PK(l3, h3), od, 0, 0, 0);
#undef PK
}
__device__ __forceinline__ void pv_d0(f32x16* o, int vb, bf16x8 pa0, bf16x8 pa1, bf16x8 pa2, bf16x8 pa3) {
  pv_one<0>(o[0], vb, pa0, pa1, pa2, pa3); pv_one<1>(o[1], vb, pa0, pa1, pa2, pa3); pv_one<2>(o[2], vb, pa0, pa1, pa2, pa3); pv_one<3>(o[3], vb, pa0, pa1, pa2, pa3);
}

template <typename TQ>
__device__ __forceinline__ void attn_dense_body(const TQ* __restrict__ Qb, const bf16* __restrict__ Kh, const bf16* __restrict__ Vh,
                                                bf16* __restrict__ Ob, int seq, char* lds) {
  using St = Stage<bf16>; using SQ = Stage<TQ>;
  const int tid = threadIdx.x, wid = tid >> 6, lane = tid & 63, r32 = lane & 31, hi = lane >> 5;
  bf16* V_lds = (bf16*)lds; bf16* K_lds = (bf16*)(lds + 2 * SHM_V);
  float* ws = (float*)(lds + 2 * SHM_V + 2 * SHM_K) + wid * 64; float* li_l = ws; float* al_l = ws + 32;
  float m_reg = -1e30f, l_reg = 0; f32x16 o[4] = {}; bf16x8 qr[8];
  const TQ* Qw = Qb + (long)(wid * QBLK + r32) * LDQ + hi * 8;
#pragma unroll
  for (int d0 = 0; d0 < 8; ++d0) qr[d0] = SQ::tobf(SQ::ld8(Qw + d0 * 16));
  const int sr = tid >> 4, sc = (tid & 15) * 8, vst0 = v_st(sr, sc), vst1 = v_st(32 + sr, sc);
  const int vb0 = (int)(uintptr_t)V_lds + v_rd_base(lane);
  struct { typename St::T vs0, vs1, ks0, ks1; } sr_[SDEPTH];
#define SLOAD(i, k0) do { sr_[i].vs0 = St::ld8(&Vh[(long)((k0) + sr) * LDK + sc]); sr_[i].vs1 = St::ld8(&Vh[(long)((k0) + 32 + sr) * LDK + sc]); \
    sr_[i].ks0 = St::ld8(&Kh[(long)((k0) + sr) * LDK + sc]); sr_[i].ks1 = St::ld8(&Kh[(long)((k0) + 32 + sr) * LDK + sc]); } while (0)
#define SWRITE(b, i) do { *(bf16x8*)((char*)V_lds + (b) * SHM_V + vst0) = St::tobf(sr_[i].vs0);          \
    *(bf16x8*)((char*)V_lds + (b) * SHM_V + vst1) = St::tobf(sr_[i].vs1); int kc = sc * 2;               \
    *(bf16x8*)((char*)K_lds + (b) * SHM_K + KSWZ(sr, kc)) = St::tobf(sr_[i].ks0);                       \
    *(bf16x8*)((char*)K_lds + (b) * SHM_K + KSWZ(32 + sr, kc)) = St::tobf(sr_[i].ks1); } while (0)
#define SWAIT() do { if constexpr (SDEPTH == 2) asm volatile("s_waitcnt vmcnt(4)" ::: "memory"); else asm volatile("s_waitcnt vmcnt(0)" ::: "memory"); } while (0)
#define RESC(a) do { if (__any((a) < 1.f)) { if (hi == 0) al_l[r32] = (a); asm volatile("s_waitcnt lgkmcnt(0)" ::: "memory"); \
    for (int d = 0; d < 4; ++d) for (int r = 0; r < 16; ++r) o[d][r] *= al_l[crow(r, hi)]; } } while (0)
  f32x16 pA0, pA1, pB0, pB1; float mnA, mnB, alA, alB; bf16x8 pa0, pa1, pa2, pa3; const int NT = seq / KVBLK;
  constexpr int SE = 0, SO = SDEPTH - 1;
  SLOAD(SE, 0); asm volatile("s_waitcnt vmcnt(0)" ::: "memory"); SWRITE(0, SE); __syncthreads();
  qkt(pA0, pA1, K_lds, qr, r32, hi); partialSM(pA0, pA1, m_reg, mnA, alA);
  SLOAD(SO, KVBLK); if constexpr (SDEPTH == 2) { if (2 < NT) SLOAD(SE, 2 * KVBLK); }
  SWAIT(); SWRITE(1, SO); __syncthreads();
  for (int j = 1; j + 1 < NT; j += 2) {
    SBAR(); qkt(pB0, pB1, (bf16*)((char*)K_lds + SHM_K), qr, r32, hi);
    finishSM(pA0, pA1, alA, l_reg, pa0, pa1, pa2, pa3); SBAR();
    SLOAD(SO, (j + SDEPTH) * KVBLK); SBAR();
    pv_d0(o, vb0, pa0, pa1, pa2, pa3); partialSM(pB0, pB1, m_reg, mnB, alB);
    __syncthreads(); SWAIT(); SWRITE(0, SE);
    RESC(alB); __syncthreads();
    SBAR(); qkt(pA0, pA1, K_lds, qr, r32, hi);
    finishSM(pB0, pB1, alB, l_reg, pa0, pa1, pa2, pa3); SBAR();
    if (SDEPTH == 1 || j + 3 < NT) SLOAD(SE, (j + 1 + SDEPTH) * KVBLK); SBAR();
    pv_d0(o, vb0 + (int)SHM_V, pa0, pa1, pa2, pa3); partialSM(pA0, pA1, m_reg, mnA, alA);
    __syncthreads(); SWAIT(); SWRITE(1, SO);
    RESC(alA); __syncthreads();
  }
  SBAR(); qkt(pB0, pB1, (bf16*)((char*)K_lds + SHM_K), qr, r32, hi);
  finishSM(pA0, pA1, alA, l_reg, pa0, pa1, pa2, pa3); SBAR();
  pv_d0(o, vb0, pa0, pa1, pa2, pa3); partialSM(pB0, pB1, m_reg, mnB, alB);
  __syncthreads(); RESC(alB);
  finishSM(pB0, pB1, alB, l_reg, pa0, pa1, pa2, pa3); SBAR();
  pv_d0(o, vb0 + (int)SHM_V, pa0, pa1, pa2, pa3);
  if (hi == 0) li_l[r32] = l_reg; asm volatile("s_waitcnt lgkmcnt(0)" ::: "memory");
  float rli[16];
#pragma unroll
  for (int r = 0; r < 16; ++r) rli[r] = __builtin_amdgcn_rcpf(li_l[crow(r, hi)]);
  bf16* Ow = Ob + (long)(wid * QBLK) * LDO;
#pragma unroll
  for (int r = 0; r < 16; ++r) { int orow = crow(r, hi);
#pragma unroll
    for (int d0 = 0; d0 < 4; ++d0) Ow[(long)orow * LDO + d0 * 32 + r32] = __float2bfloat16(o[d0][r] * rli[r]); }
#undef SLOAD
#undef SWRITE
#undef SWAIT
#undef RESC
}
#undef KSWZ
#undef SBAR
}
#ifndef MK_MULTI
#define MK_MULTI 0
#endif
constexpr int NWAVES = 8, NTHR = 512;
constexpr int BATCH = 32, SEQ = 2048, DM = 1024, CTXL = 256, DFF = 4096, NIN = 4096;
constexpr int MLAT = BATCH * SEQ;
constexpr int MCTX = BATCH * CTXL;
constexpr int MALL = MLAT + MCTX;
constexpr int NMOD = 6 * DM;
constexpr float EPS = 1e-6f;
constexpr size_t MiB = 1u << 20;
constexpr size_t WS_MOD = 0;
constexpr size_t WS_COS = 1 * MiB, WS_SIN = WS_COS + 8192;
constexpr size_t WS_WIN = 2 * MiB, WS_WAU = 10 * MiB, WS_WPU = 12 * MiB, WS_WGB = 13 * MiB, WS_WOUT = 14 * MiB, WS_WF1 = 16 * MiB, WS_WF2 = 24 * MiB;
constexpr size_t WS_XN = 32 * MiB;
constexpr size_t WS_AO = WS_XN;
constexpr size_t WS_Q = 176 * MiB;
constexpr size_t WS_T = WS_Q;
constexpr size_t WS_K = 304 * MiB, WS_V = 340 * MiB;
constexpr size_t WS_PI = 376 * MiB;
constexpr size_t WS_MIX = WS_PI;
constexpr size_t WS_PLD = 440 * MiB;
constexpr size_t WS_GT = 504 * MiB;
constexpr size_t WS_Y = WS_GT;
constexpr size_t WS_MB = 760 * MiB;
constexpr size_t WS_XN2 = WS_MB;
constexpr size_t WS_F = 32 * MiB;
constexpr size_t WS_Z = 544 * MiB;
constexpr size_t WS_END = 888 * MiB;
constexpr int RING_BYTES = 131072, EXCH_OFF = RING_BYTES, LDS_BYTES = 147456;

#define GAS __attribute__((address_space(1)))
#define LAS __attribute__((address_space(3)))
typedef unsigned short bf16;
typedef unsigned v4u __attribute__((ext_vector_type(4)));
typedef float f32x4 __attribute__((ext_vector_type(4)));
#define LDS_WAIT() asm volatile("s_waitcnt lgkmcnt(0)" ::: "memory")
__device__ __forceinline__ unsigned f2bf(float f) { unsigned u = __builtin_bit_cast(unsigned, f); return (u + 0x7fffu + ((u >> 16) & 1u)) >> 16; }
__device__ __forceinline__ unsigned pk2(float lo, float hi) { return f2bf(lo) | (f2bf(hi) << 16); }
__device__ __forceinline__ float bfl(unsigned u) { return __uint_as_float(u << 16); }
__device__ __forceinline__ float bfh(unsigned u) { return __uint_as_float(u & 0xffff0000u); }
__device__ __forceinline__ float wave_sum(float v) {
#pragma unroll
    for (int o = 1; o < 64; o <<= 1) v += __shfl_xor(v, o);
    return v;
}
__device__ __forceinline__ int perm7(int d) { return (d & 0x43) | ((d & 0x10) << 1) | ((d & 0x0C) << 1) | ((d & 0x20) >> 3); }

struct Frame {
    LAS unsigned char* lds;
    int tid, lane, wave, vcu, G;
    const float* in[21]; float* out; unsigned char* ws;
};
template <bool QKPERM>
__device__ __forceinline__ void p0_transpose_item(const float* W, int K, int N, bf16* WT, LAS float* scr, int item, int lane) {
    const int nblk = N / 32, kb = item / nblk, nb = item % nblk, k0 = 64 * kb, n0 = 32 * nb;
#pragma unroll 8
    for (int i = 0; i < 32; ++i) { const int kk = 2 * i + (lane >> 5); scr[kk * 33 + (lane & 31)] = W[(size_t)(k0 + kk) * N + n0 + (lane & 31)]; }
    LDS_WAIT(); asm volatile("" ::: "memory");
    const int c = lane & 7;
#pragma unroll
    for (int j = 0; j < 4; ++j) { const int n = (lane >> 3) + 8 * j; const LAS float* s = scr + (8 * c) * 33 + n;
        v4u o; o.x = pk2(s[0 * 33], s[1 * 33]); o.y = pk2(s[2 * 33], s[3 * 33]); o.z = pk2(s[4 * 33], s[5 * 33]); o.w = pk2(s[6 * 33], s[7 * 33]);
        int row = n0 + n; if (QKPERM && row < 1280) row = (row & ~127) | perm7(row & 127);
        *(GAS v4u*)(WT + (size_t)row * K + k0 + 8 * c) = o; }
    LDS_WAIT(); asm volatile("" ::: "memory");
}
__device__ __forceinline__ void mod_unit(Frame& F, int u) {
    LAS float* sc = (LAS float*)F.lds;
    LAS float* red = (LAS float*)(F.lds + 73728);
    const float* c = F.in[1]; const float* cctx = F.in[3]; const float* wmod = F.in[4]; const float* bmod = F.in[5];
    float* MOD = (float*)(F.ws + WS_MOD);
    const int col = F.tid & 31, ks = F.tid >> 5, n0 = 32 * u;
    float acc[33];
#pragma unroll
    for (int r = 0; r < 33; ++r) acc[r] = 0.f;
    for (int half = 0; half < 2; ++half) {
        __syncthreads();
        for (int idx = F.tid; idx < 512 * 36; idx += NTHR) { const int k = idx / 36, r = idx - k * 36, kk = half * 512 + k;
            float v = 0.f; if (r < 32) v = c[r * DM + kk]; else if (r == 32) v = cctx[kk];
            sc[idx] = v / (1.0f + __expf(-v)); }
        __syncthreads();
        for (int i = 0; i < 32; ++i) { const int k = ks * 32 + i; const float w = wmod[(size_t)(half * 512 + k) * NMOD + n0 + col];
#pragma unroll
            for (int r4 = 0; r4 < 8; ++r4) { const f32x4 s = *(const LAS f32x4*)(sc + k * 36 + 4 * r4);
                acc[4 * r4 + 0] += s[0] * w; acc[4 * r4 + 1] += s[1] * w; acc[4 * r4 + 2] += s[2] * w; acc[4 * r4 + 3] += s[3] * w; }
            acc[32] += sc[k * 36 + 32] * w; }
    }
#pragma unroll
    for (int r = 0; r < 33; ++r) red[(ks * 33 + r) * 32 + col] = acc[r];
    __syncthreads();
    for (int idx = F.tid; idx < 33 * 32; idx += NTHR) { const int r = idx >> 5, cc = idx & 31; float s = 0.f;
#pragma unroll
        for (int k = 0; k < 16; ++k) s += red[(k * 33 + r) * 32 + cc];
        MOD[r * NMOD + n0 + cc] = s + bmod[n0 + cc]; }
    __syncthreads();
}
__device__ __forceinline__ void p0_prologue(Frame& F) {
    for (int u = blockIdx.x; u < NMOD / 32; u += F.G) mod_unit(F, u);
    __syncthreads();
    LAS float* scr = (LAS float*)(F.lds + F.wave * 16384);
    const int gw = F.vcu * NWAVES + F.wave, NGW = F.G * NWAVES;
    constexpr int I_IN = (DM / 64) * (NIN / 32), I_AU = (DM / 64) * (DM / 32), I_PU = (512 / 64) * (DM / 32), I_OUT = I_AU, I_F1 = (DM / 64) * (DFF / 32), I_F2 = (DFF / 64) * (DM / 32);
    constexpr int NITEMS = I_IN + I_AU + I_PU + I_OUT + I_F1 + I_F2;
    for (int it = gw; it < NITEMS; it += NGW) {
        int r = it;
        if (r < I_IN) { p0_transpose_item<true>(F.in[10], DM, NIN, (bf16*)(F.ws + WS_WIN), scr, r, F.lane); continue; } r -= I_IN;
        if (r < I_AU) { p0_transpose_item<false>(F.in[14], DM, DM, (bf16*)(F.ws + WS_WAU), scr, r, F.lane); continue; } r -= I_AU;
        if (r < I_PU) { p0_transpose_item<false>(F.in[17], 512, DM, (bf16*)(F.ws + WS_WPU), scr, r, F.lane); continue; } r -= I_PU;
        if (r < I_OUT) { p0_transpose_item<false>(F.in[18], DM, DM, (bf16*)(F.ws + WS_WOUT), scr, r, F.lane); continue; } r -= I_OUT;
        if (r < I_F1) { p0_transpose_item<false>(F.in[19], DM, DFF, (bf16*)(F.ws + WS_WF1), scr, r, F.lane); continue; } r -= I_F1;
        p0_transpose_item<false>(F.in[20], DFF, DM, (bf16*)(F.ws + WS_WF2), scr, r, F.lane);
    }
    { const float* wg = F.in[15]; bf16* WG = (bf16*)(F.ws + WS_WGB); const int gt = blockIdx.x * NTHR + F.tid, NT = F.G * NTHR;
      for (int idx = gt; idx < 512 * 512; idx += NT) { const int n = idx >> 9, k = idx & 511, g = n >> 7;
          WG[idx] = ((k >> 7) == g) ? (bf16)f2bf(wg[(size_t)(g * 128 + (k & 127)) * 128 + (n & 127)]) : (bf16)0; }
      float* cosT = (float*)(F.ws + WS_COS); float* sinT = (float*)(F.ws + WS_SIN);
      if (gt < 2048) { const int pos = gt >> 5, j = gt & 31; const float fr = powf(10000.0f, -(float)j / 32.0f), ang = (float)pos * fr; cosT[gt] = cosf(ang); sinT[gt] = sinf(ang); } }
}
__device__ __forceinline__ void p1_rows(Frame& F) {
    const int gw = F.vcu * NWAVES + F.wave, NGW = F.G * NWAVES;
    const float* MOD = (const float*)(F.ws + WS_MOD); const float* g = F.in[6]; bf16* XN = (bf16*)(F.ws + WS_XN);
    f32x4 gv[4];
#pragma unroll
    for (int j = 0; j < 4; ++j) gv[j] = *((const f32x4*)g + F.lane + 64 * j);
    for (int m = gw; m < MALL; m += NGW) {
        const float* src = m < MLAT ? F.in[0] + (size_t)m * DM : F.in[2] + (size_t)(m - MLAT) * DM;
        const float* mr = MOD + (size_t)(m < MLAT ? (m >> 11) : 32) * NMOD;
        const f32x4* xr = (const f32x4*)src + F.lane; f32x4 v[4]; float s = 0.f;
#pragma unroll
        for (int j = 0; j < 4; ++j) { v[j] = xr[64 * j]; s += (v[j].x * v[j].x + v[j].y * v[j].y) + (v[j].z * v[j].z + v[j].w * v[j].w); }
        const float rstd = rsqrtf(wave_sum(s) * (1.f / DM) + EPS);
        unsigned long long* o8 = (unsigned long long*)(XN + (size_t)m * DM) + F.lane;
#pragma unroll
        for (int j = 0; j < 4; ++j) { const f32x4 sh = *((const f32x4*)mr + F.lane + 64 * j), sc = *((const f32x4*)(mr + DM) + F.lane + 64 * j);
            const f32x4 h = (v[j] * rstd * gv[j]) * (sc + 1.0f) + sh;
            o8[64 * j] = (unsigned long long)pk2(h.x, h.y) | ((unsigned long long)pk2(h.z, h.w) << 32); }
    }
}
__device__ __forceinline__ void p3_pool(Frame& F) {
    const bf16* PI = (const bf16*)(F.ws + WS_PI); bf16* PL = (bf16*)(F.ws + WS_PLD);
    const int gt = blockIdx.x * NTHR + F.tid, NT = F.G * NTHR;
    for (int item = gt; item < MLAT * 64; item += NT) {
        const int ch = item & 63, row = item >> 6, g = ch >> 4, hw = 1 << g, t = row & (SEQ - 1);
        const int lo = t - hw < 0 ? 0 : t - hw, hi = t + hw > SEQ ? SEQ : t + hw;
        const bf16* base = PI + (size_t)(row - t) * 512 + ch * 8;
        float a[8];
#pragma unroll
        for (int e = 0; e < 8; ++e) a[e] = 0.f;
        for (int s = lo; s < hi; ++s) { const v4u w = *(const v4u*)(base + (size_t)s * 512);
            a[0] += bfl(w.x); a[1] += bfh(w.x); a[2] += bfl(w.y); a[3] += bfh(w.y); a[4] += bfl(w.z); a[5] += bfh(w.z); a[6] += bfl(w.w); a[7] += bfh(w.w); }
        const v4u w = *(const v4u*)(base + (size_t)t * 512); const float inv = 1.0f / (float)(hi - lo);
        v4u o; o.x = pk2(a[0] * inv - bfl(w.x), a[1] * inv - bfh(w.x)); o.y = pk2(a[2] * inv - bfl(w.y), a[3] * inv - bfh(w.y));
        o.z = pk2(a[4] * inv - bfl(w.z), a[5] * inv - bfh(w.z)); o.w = pk2(a[6] * inv - bfl(w.w), a[7] * inv - bfh(w.w));
        *(v4u*)(PL + (size_t)row * 512 + ch * 8) = o;
    }
}
__device__ __forceinline__ void p7_rows(Frame& F) {
    const int gw = F.vcu * NWAVES + F.wave, NGW = F.G * NWAVES;
    const float* MOD = (const float*)(F.ws + WS_MOD); const float* Y = (const float*)(F.ws + WS_Y); bf16* XN2 = (bf16*)(F.ws + WS_XN2);
    const float* gpo = F.in[7]; const float* gpr = F.in[8];
    for (int m = gw; m < MLAT; m += NGW) {
        const float* mr = MOD + (size_t)(m >> 11) * NMOD;
        const f32x4* yr = (const f32x4*)(Y + (size_t)m * DM) + F.lane; const f32x4* xr = (const f32x4*)(F.in[0] + (size_t)m * DM) + F.lane;
        f32x4 y[4], x[4]; float s = 0.f;
#pragma unroll
        for (int j = 0; j < 4; ++j) { y[j] = yr[64 * j]; x[j] = xr[64 * j]; s += (y[j].x * y[j].x + y[j].y * y[j].y) + (y[j].z * y[j].z + y[j].w * y[j].w); }
        const float rstd = rsqrtf(wave_sum(s) * (1.f / DM) + EPS); float s2 = 0.f;
        f32x4* orow = (f32x4*)(F.out + (size_t)m * DM) + F.lane;
#pragma unroll
        for (int j = 0; j < 4; ++j) { const f32x4 ga = *((const f32x4*)(mr + 2 * DM) + F.lane + 64 * j), gg = *((const f32x4*)gpo + F.lane + 64 * j);
            x[j] = x[j] + ga * (y[j] * rstd * gg); orow[64 * j] = x[j];
            s2 += (x[j].x * x[j].x + x[j].y * x[j].y) + (x[j].z * x[j].z + x[j].w * x[j].w); }
        const float rstd2 = rsqrtf(wave_sum(s2) * (1.f / DM) + EPS);
        unsigned long long* o8 = (unsigned long long*)(XN2 + (size_t)m * DM) + F.lane;
#pragma unroll
        for (int j = 0; j < 4; ++j) { const f32x4 sh = *((const f32x4*)(mr + 3 * DM) + F.lane + 64 * j), sc = *((const f32x4*)(mr + 4 * DM) + F.lane + 64 * j), gg = *((const f32x4*)gpr + F.lane + 64 * j);
            const f32x4 h = (x[j] * rstd2 * gg) * (sc + 1.0f) + sh;
            o8[64 * j] = (unsigned long long)pk2(h.x, h.y) | ((unsigned long long)pk2(h.z, h.w) << 32); }
    }
}
__device__ __forceinline__ void p10_rows(Frame& F) {
    const int gw = F.vcu * NWAVES + F.wave, NGW = F.G * NWAVES;
    const float* MOD = (const float*)(F.ws + WS_MOD); const float* Z = (const float*)(F.ws + WS_Z); const float* gpo = F.in[9];
    for (int m = gw; m < MLAT; m += NGW) {
        const float* mr = MOD + (size_t)(m >> 11) * NMOD;
        const f32x4* zr = (const f32x4*)(Z + (size_t)m * DM) + F.lane; f32x4* orow = (f32x4*)(F.out + (size_t)m * DM) + F.lane;
        f32x4 z[4], x[4]; float s = 0.f;
#pragma unroll
        for (int j = 0; j < 4; ++j) { z[j] = zr[64 * j]; x[j] = orow[64 * j]; s += (z[j].x * z[j].x + z[j].y * z[j].y) + (z[j].z * z[j].z + z[j].w * z[j].w); }
        const float rstd = rsqrtf(wave_sum(s) * (1.f / DM) + EPS);
#pragma unroll
        for (int j = 0; j < 4; ++j) { const f32x4 ga = *((const f32x4*)(mr + 5 * DM) + F.lane + 64 * j), gg = *((const f32x4*)gpo + F.lane + 64 * j);
            orow[64 * j] = x[j] + ga * (z[j] * rstd * gg); }
    }
}

constexpr int NPHASE = 11;
struct Args { const float* in[21]; float* out; unsigned char* ws; int ph_lo, ph_hi; };
__global__ void __launch_bounds__(NTHR, 2) fwd_mega(Args args) {
    extern __shared__ __attribute__((aligned(16))) unsigned char lds[];
    cg::grid_group grid = cg::this_grid();
    Frame F;
    F.lds = (LAS unsigned char*)lds;
    F.tid = threadIdx.x; F.lane = F.tid & 63; F.wave = __builtin_amdgcn_readfirstlane(F.tid >> 6);
    F.G = gridDim.x; { const int bx = blockIdx.x; F.vcu = (F.G % 8 == 0) ? (bx % 8) * (F.G / 8) + bx / 8 : bx; }
#pragma unroll
    for (int i = 0; i < 21; ++i) F.in[i] = args.in[i];
    F.out = args.out; F.ws = args.ws;
    unsigned char* ws = args.ws;
    const int lo = args.ph_lo, hi = args.ph_hi;
#define IN(k) (lo <= (k) && (k) < hi)
#define SEAM(k) do { if (IN(k) && IN((k) + 1)) grid.sync(); } while (0)
    typedef pg8::bf16_t pb;
    if (IN(0)) { p0_prologue(F); } SEAM(0);
    if (IN(1)) { p1_rows(F); } SEAM(1);
    if (IN(2)) {
        pg8::Gemm g{(const pb*)(ws + WS_XN), (const pb*)(ws + WS_WIN), MALL, NIN, DM};
        pg8::InprojOrder S; S.init(F.G, (int)blockIdx.x);
        pg8::EpiInproj E{(pb*)(ws + WS_Q), (pb*)(ws + WS_K), (pb*)(ws + WS_V), (pb*)(ws + WS_PI), (pb*)(ws + WS_GT), F.in[12], F.in[13], F.in[11],
                         (const float*)(ws + WS_COS), (const float*)(ws + WS_SIN), (PG8_LAS float*)(F.lds + EXCH_OFF)};
        pg8::gemm_phase<pg8::EpiInproj, pg8::InprojOrder, true, true>(F.lds, g, S, E);
    } SEAM(2);
    if (IN(3)) {
        const attn::bf16* Q = (const attn::bf16*)(ws + WS_Q); const attn::bf16* K = (const attn::bf16*)(ws + WS_K); const attn::bf16* V = (const attn::bf16*)(ws + WS_V); attn::bf16* AO = (attn::bf16*)(ws + WS_AO);
        for (int u = blockIdx.x; u < BATCH * 8 * 8; u += F.G) {
            const int pair = (u >> 8) * 8 + (u & 7), idx = (u & 255) >> 3, gq = idx >> 3, qb = idx & 7, b = pair >> 1, kvh = pair & 1, h = kvh * 4 + gq;
            const size_t qoff = ((size_t)b * SEQ + qb * 256) * 1024 + h * 128, koff = (size_t)b * pg8::KVROWS * 256 + kvh * 128;
            attn::attn_dense_body<attn::bf16>(Q + qoff, K + koff, V + koff, AO + qoff, pg8::KVROWS, (char*)lds);
            __syncthreads();
        }
        p3_pool(F);
    } SEAM(3);
    if (IN(4)) {
        pg8::Gemm g{(const pb*)(ws + WS_PLD), (const pb*)(ws + WS_WGB), MLAT, 512, 512};
        pg8::StaticOrder S; S.init(MLAT, 512, F.G, (int)blockIdx.x);
        pg8::EpiGen<0> E{(pb*)(ws + WS_MIX), 512, F.in[16], nullptr, 0, nullptr};
        pg8::gemm_phase<pg8::EpiGen<0>, pg8::StaticOrder, true, true>(F.lds, g, S, E);
    } SEAM(4);
    if (IN(5)) {
        { pg8::Gemm g{(const pb*)(ws + WS_MIX), (const pb*)(ws + WS_WPU), MLAT, DM, 512};
          pg8::StaticOrder S; S.init(MLAT, DM, F.G, (int)blockIdx.x);
          pg8::EpiGen<1> E{(pb*)(ws + WS_T), DM, nullptr, (const pb*)(ws + WS_GT), DM, nullptr};
          pg8::gemm_phase<pg8::EpiGen<1>, pg8::StaticOrder, true, true>(F.lds, g, S, E); }
        { pg8::Gemm g{(const pb*)(ws + WS_AO), (const pb*)(ws + WS_WAU), MLAT, DM, DM};
          pg8::StaticOrder S; S.init(MLAT, DM, F.G, (int)blockIdx.x);
          pg8::EpiGen<2> E{(pb*)(ws + WS_MB), DM, nullptr, (const pb*)(ws + WS_GT), 0, (const pb*)(ws + WS_T)};
          pg8::gemm_phase<pg8::EpiGen<2>, pg8::StaticOrder, true, true>(F.lds, g, S, E); }
    } SEAM(5);
    if (IN(6)) {
        pg8::Gemm g{(const pb*)(ws + WS_MB), (const pb*)(ws + WS_WOUT), MLAT, DM, DM};
        pg8::StaticOrder S; S.init(MLAT, DM, F.G, (int)blockIdx.x);
        pg8::EpiF32 E{(float*)(ws + WS_Y), DM};
        pg8::gemm_phase<pg8::EpiF32, pg8::StaticOrder, true, true>(F.lds, g, S, E);
    } SEAM(6);
    if (IN(7)) { p7_rows(F); } SEAM(7);
    if (IN(8)) {
        pg8::Gemm g{(const pb*)(ws + WS_XN2), (const pb*)(ws + WS_WF1), MLAT, DFF, DM};
        pg8::StaticOrder S; S.init(MLAT, DFF, F.G, (int)blockIdx.x);
        pg8::EpiGen<3> E{(pb*)(ws + WS_F), DFF, nullptr, nullptr, 0, nullptr};
        pg8::gemm_phase<pg8::EpiGen<3>, pg8::StaticOrder, true, true>(F.lds, g, S, E);
    } SEAM(8);
    if (IN(9)) {
        pg8::Gemm g{(const pb*)(ws + WS_F), (const pb*)(ws + WS_WF2), MLAT, DM, DFF};
        pg8::StaticOrder S; S.init(MLAT, DM, F.G, (int)blockIdx.x);
        pg8::EpiF32 E{(float*)(ws + WS_Z), DM};
        pg8::gemm_phase<pg8::EpiF32, pg8::StaticOrder, true, true>(F.lds, g, S, E);
    } SEAM(9);
    if (IN(10)) { p10_rows(F); }
#undef IN
#undef SEAM
}

extern "C" void kernel_launch(void* const* d_in, const int* in_sizes, int n_in, void* d_out, int out_size, void* d_ws, size_t ws_size, hipStream_t stream) {
    static int grid = 0;
    if (grid == 0) {
        if (n_in != 21 || out_size != MLAT * DM || ws_size < WS_END) { fprintf(stderr, "kernel_launch: unexpected shapes: n_in %d out %d ws %zu (need %zu)\n", n_in, out_size, ws_size, (size_t)WS_END); grid = -1; return; }
        int dev = 0, cus = 0, per_cu = 0;
        if (hipGetDevice(&dev) != hipSuccess || hipDeviceGetAttribute(&cus, hipDeviceAttributeMultiprocessorCount, dev) != hipSuccess) { grid = -1; return; }
        if (hipFuncSetAttribute((const void*)fwd_mega, hipFuncAttributeMaxDynamicSharedMemorySize, LDS_BYTES) != hipSuccess) { fprintf(stderr, "kernel_launch: hipFuncSetAttribute failed\n"); grid = -1; return; }
        if (hipOccupancyMaxActiveBlocksPerMultiprocessor(&per_cu, (const void*)fwd_mega, NTHR, LDS_BYTES) != hipSuccess || per_cu < 1) per_cu = 1;
        (void)hipGetLastError();
        grid = cus * per_cu;
    }
    if (grid < 0) return;
    Args a{};
    for (int i = 0; i < 21; ++i) a.in[i] = (const float*)d_in[i];
    a.out = (float*)d_out; a.ws = (unsigned char*)d_ws;
#if MK_MULTI
    for (int p = 0; p < NPHASE; ++p) { a.ph_lo = p; a.ph_hi = p + 1; hipLaunchKernelGGL(fwd_mega, dim3(grid), dim3(NTHR), LDS_BYTES, stream, a); }
#else
    a.ph_lo = 0; a.ph_hi = NPHASE;
    void* kargs[] = {&a};
    const hipError_t e = hipLaunchCooperativeKernel((const void*)fwd_mega, dim3(grid), dim3(NTHR), kargs, LDS_BYTES, stream);
    if (e != hipSuccess) fprintf(stderr, "kernel_launch: cooperative launch failed: %s (grid %d)\n", hipGetErrorString(e), grid);
#endif
}
```

```cpp
#include <hip/hip_runtime.h>
#include <hip/hip_cooperative_groups.h>
#include <hip/hip_bf16.h>
#include <cstdio>
#include <cstdint>
#include <cmath>
namespace cg = cooperative_groups;
namespace pg8 {
#define PG8_LAS __attribute__((address_space(3)))
typedef unsigned short bf16_t;
typedef short bf16x8 __attribute__((ext_vector_type(8)));
typedef float f32x4 __attribute__((ext_vector_type(4)));
typedef unsigned u32x4 __attribute__((ext_vector_type(4)));
constexpr int BM = 256, BK = 64, HALF = 128, HTB = HALF * BK * 2  , STAGE_BYTES = 8 * HTB, NXCD = 8, WGM = 8;

__host__ __device__ __forceinline__ int lds_byte(int r, int c) { const int st = (r >> 4) * 2 + (c >> 5), rr = r & 15, cc = c & 31, ob = rr * 64 + cc * 2; return st * 1024 + (ob ^ (((ob >> 9) & 1) << 5)); }
__host__ __device__ __forceinline__ void stage_rc(int b, int& R, int& C) { const int st = b / 1024, sb = b % 1024, swz = sb ^ (((sb >> 9) & 1) << 5); R = (st >> 1) * 16 + swz / 64; C = (st & 1) * 32 + (swz % 64) / 2; }
__host__ __device__ __forceinline__ int perm32(int rho) { const int n = rho >> 4, i = rho & 15; return 8 * (i >> 2) + 4 * n + (i & 3); }

struct Unit { int pm, pn; };
struct Gemm { const bf16_t* A; const bf16_t* Bt; int M, N, K; };

struct StaticOrder {
    int nM, nN, nwg, G, c;
    __host__ __device__ void init(int M, int N, int G_, int c_) { nM = M / BM; nN = N / BM; nwg = nM * nN; G = G_; c = c_; }
    __host__ __device__ bool next(int i, Unit& u) const {
        const long L = (long)i * G + c; if (L >= nwg) return false;
        int wgid = (int)L; { const int q = nwg / NXCD, r = nwg % NXCD, xcd = wgid % NXCD, off = wgid / NXCD; wgid = (xcd < r ? xcd * (q + 1) : r * (q + 1) + (xcd - r) * q) + off; }
        const int nig = WGM * nN, gid = wgid / nig, fm = gid * WGM, gsz = (nM - fm) < WGM ? (nM - fm) : WGM;
        u.pm = fm + ((wgid % nig) % gsz); u.pn = (wgid % nig) / gsz; return true;
    }
    __device__ __forceinline__ void a_ready(const Unit&) const {}
    __device__ __forceinline__ void done(const Unit&) const {}
};

__device__ __forceinline__ unsigned cvt_pk_bf16(float lo, float hi) { unsigned r; asm volatile("v_cvt_pk_bf16_f32 %0, %1, %2" : "=v"(r) : "v"(lo), "v"(hi)); return r; }
typedef float f32x2 __attribute__((ext_vector_type(2)));
__device__ __forceinline__ float bf_lo(unsigned u) { return __uint_as_float(u << 16); }
__device__ __forceinline__ float bf_hi(unsigned u) { return __uint_as_float(u & 0xffff0000u); }
__device__ __forceinline__ float sigmoidf_fast(float x) { return __builtin_amdgcn_rcpf(1.0f + __expf(-x)); }
typedef unsigned u32x2 __attribute__((ext_vector_type(2)));
constexpr int KVROWS = 2304;

struct EpiInproj {
    static constexpr bool PERM = true, AFTER_DRAIN = false;
    bf16_t *Q, *Kb, *Vb, *PI, *GT; const float *gq, *gk, *bgate, *cosT, *sinT; PG8_LAS float* exch;
    __device__ __forceinline__ void operator()(const f32x4 (&acc)[2][2][4][2], const Unit& u, int wr, int wc, int fr, int fq) const {
        const int pn = u.pn, pm = u.pm;
        const bool isctx = pm >= 256;
        const int rl0 = wr * 64 + fr;
        const int kvbase = isctx ? (pm - 256) * KVROWS : (pm >> 3) * KVROWS + 256 + (pm & 7) * 256;
        if (pn < 5) {
#pragma unroll
            for (int ai = 0; ai < 2; ++ai)
#pragma unroll
                for (int m = 0; m < 4; ++m)
#pragma unroll
                    for (int bj = 0; bj < 2; ++bj) {
                        const f32x4 a = acc[ai][bj][m][0], b = acc[ai][bj][m][1];
                        float s = (a[0] * a[0] + a[1] * a[1]) + (a[2] * a[2] + a[3] * a[3]) + (b[0] * b[0] + b[1] * b[1]) + (b[2] * b[2] + b[3] * b[3]);
                        s += __shfl_xor(s, 16); s += __shfl_xor(s, 32);
                        if (fq == 0) exch[((ai * HALF + rl0 + m * 16) * 2 + bj) * 4 + wc] = s;
                    }
            asm volatile("s_waitcnt lgkmcnt(0)" ::: "memory"); __builtin_amdgcn_s_barrier(); asm volatile("" ::: "memory");
            const int hh = wc >> 1, j0 = 16 * (wc & 1) + 4 * fq;
            const float* gain = (pn < 4) ? gq : gk;
            const f32x4 g1 = *(const f32x4*)(gain + 64 * hh + j0), g2 = *(const f32x4*)(gain + 64 * hh + 32 + j0);
#pragma unroll
            for (int ai = 0; ai < 2; ++ai)
#pragma unroll
                for (int m = 0; m < 4; ++m) {
                    const int rl = ai * HALF + rl0 + m * 16;
                    const int t = (pm & 7) * 256 + rl;
                    const int pos = hh == 0 ? (t >> 6) : (t & 63);
                    f32x4 c4 = (f32x4){1.f, 1.f, 1.f, 1.f}, s4 = (f32x4){0.f, 0.f, 0.f, 0.f};
                    if (!isctx) { c4 = *(const f32x4*)(cosT + pos * 32 + j0); s4 = *(const f32x4*)(sinT + pos * 32 + j0); }
#pragma unroll
                    for (int bj = 0; bj < 2; ++bj) {
                        const f32x4 p4 = *(const PG8_LAS f32x4*)(exch + (rl * 2 + bj) * 4);
                        const float rstd = rsqrtf(((p4[0] + p4[1]) + (p4[2] + p4[3])) * (1.0f / 128.0f) + 1e-6f);
                        const f32x4 x1 = acc[ai][bj][m][0] * rstd * g1, x2 = acc[ai][bj][m][1] * rstd * g2;
                        const f32x4 o1 = x1 * c4 - x2 * s4, o2 = x1 * s4 + x2 * c4;
                        bf16_t* dst = (pn < 4) ? Q + (size_t)(pm * BM + rl) * 1024 + (2 * pn + bj) * 128 + 64 * hh + j0
                                               : Kb + (size_t)(kvbase + rl) * 256 + bj * 128 + 64 * hh + j0;
                        u32x2 w1, w2; w1.x = cvt_pk_bf16(o1[0], o1[1]); w1.y = cvt_pk_bf16(o1[2], o1[3]); w2.x = cvt_pk_bf16(o2[0], o2[1]); w2.y = cvt_pk_bf16(o2[2], o2[3]);
                        *(u32x2*)dst = w1; *(u32x2*)(dst + 32) = w2;
                    }
                }
        } else {
            const int ct0 = wc * 32 + 8 * fq;
#pragma unroll
            for (int ai = 0; ai < 2; ++ai)
#pragma unroll
                for (int m = 0; m < 4; ++m) {
                    const int rl = ai * HALF + rl0 + m * 16;
#pragma unroll
                    for (int bj = 0; bj < 2; ++bj) {
                        const int col = bj * HALF + ct0;
                        f32x4 v0 = acc[ai][bj][m][0], v1 = acc[ai][bj][m][1];
                        bf16_t* dst;
                        if (pn == 5) dst = Vb + (size_t)(kvbase + rl) * 256 + col;
                        else if (pn < 8) dst = PI + (size_t)(pm * BM + rl) * 512 + (pn - 6) * 256 + col;
                        else {
                            const int gcol = (pn - 8) * 256 + col;
                            const f32x4 b0 = *(const f32x4*)(bgate + gcol), b1 = *(const f32x4*)(bgate + gcol + 4);
                            v0 += b0; v1 += b1;
#pragma unroll
                            for (int e = 0; e < 4; ++e) { v0[e] = sigmoidf_fast(v0[e]); v1[e] = sigmoidf_fast(v1[e]); }
                            dst = GT + (size_t)(pm * BM + rl) * 2048 + gcol;
                        }
                        u32x4 w; w.x = cvt_pk_bf16(v0[0], v0[1]); w.y = cvt_pk_bf16(v0[2], v0[3]); w.z = cvt_pk_bf16(v1[0], v1[1]); w.w = cvt_pk_bf16(v1[2], v1[3]);
                        *(u32x4*)dst = w;
                    }
                }
        }
    }
};
struct InprojOrder {
    StaticOrder so;
    __device__ void init(int G_, int c_) { so.init(65536, 4096, G_, c_); }
    __device__ bool next(int i, Unit& u) const {
        const long L = (long)i * so.G + so.c;
        if (L < so.nwg) return so.next(i, u);
        const int j = (int)(L - so.nwg); if (j >= 64) return false;
        u.pm = 256 + (j >> 1); u.pn = 4 + (j & 1); return true;
    }
    __device__ __forceinline__ void a_ready(const Unit&) const {}
    __device__ __forceinline__ void done(const Unit&) const {}
};
template <int MODE> struct EpiGen {
    static constexpr bool PERM = true, AFTER_DRAIN = false;
    bf16_t* O; int ldc; const float* scale; const bf16_t* GT; int goff; const bf16_t* T;
    __device__ __forceinline__ void operator()(const f32x4 (&acc)[2][2][4][2], const Unit& u, int wr, int wc, int fr, int fq) const {
        const int row0 = u.pm * BM + wr * 64 + fr, col0 = u.pn * BM + wc * 32 + 8 * fq;
#pragma unroll
        for (int ai = 0; ai < 2; ++ai)
#pragma unroll
            for (int m = 0; m < 4; ++m) {
                const size_t row = (size_t)(row0 + ai * HALF + m * 16);
#pragma unroll
                for (int bj = 0; bj < 2; ++bj) {
                    const int col = col0 + bj * HALF;
                    f32x4 v0 = acc[ai][bj][m][0], v1 = acc[ai][bj][m][1];
                    if (MODE == 0) { v0 *= *(const f32x4*)(scale + col); v1 *= *(const f32x4*)(scale + col + 4); }
                    if (MODE == 1 || MODE == 2) {
                        const u32x4 g = *(const u32x4*)(GT + row * 2048 + goff + col);
                        v0 *= (f32x4){bf_lo(g.x), bf_hi(g.x), bf_lo(g.y), bf_hi(g.y)}; v1 *= (f32x4){bf_lo(g.z), bf_hi(g.z), bf_lo(g.w), bf_hi(g.w)};
                    }
                    if (MODE == 2) {
                        const u32x4 t = *(const u32x4*)(T + row * ldc + col);
                        v0 += (f32x4){bf_lo(t.x), bf_hi(t.x), bf_lo(t.y), bf_hi(t.y)}; v1 += (f32x4){bf_lo(t.z), bf_hi(t.z), bf_lo(t.w), bf_hi(t.w)};
                    }
                    if (MODE == 3) {
#pragma unroll
                        for (int e = 0; e < 4; ++e) { const float a = fmaxf(v0[e], 0.f), b = fmaxf(v1[e], 0.f); v0[e] = a * a; v1[e] = b * b; }
                    }
                    u32x4 w; w.x = cvt_pk_bf16(v0[0], v0[1]); w.y = cvt_pk_bf16(v0[2], v0[3]); w.z = cvt_pk_bf16(v1[0], v1[1]); w.w = cvt_pk_bf16(v1[2], v1[3]);
                    *(u32x4*)(O + row * ldc + col) = w;
                }
            }
    }
};
struct EpiF32 {
    static constexpr bool PERM = false, AFTER_DRAIN = false;
    float* O; int ldc;
    __device__ __forceinline__ void operator()(const f32x4 (&acc)[2][2][4][2], const Unit& u, int wr, int wc, int fr, int fq) const {
        const int row0 = u.pm * BM + wr * 64 + fr, col0 = u.pn * BM + wc * 32 + 4 * fq;
#pragma unroll
        for (int ai = 0; ai < 2; ++ai)
#pragma unroll
            for (int m = 0; m < 4; ++m) {
                float* rp = O + (size_t)(row0 + ai * HALF + m * 16) * ldc + col0;
#pragma unroll
                for (int bj = 0; bj < 2; ++bj)
#pragma unroll
                    for (int n = 0; n < 2; ++n) *(f32x4*)(rp + bj * HALF + n * 16) = acc[ai][bj][m][n];
            }
    }
};

template <class Epi, class Sched, bool ALIGN_EPI = false, bool SP2 = false>
__device__ __forceinline__ void gemm_phase(PG8_LAS unsigned char* lds, const Gemm g, const Sched& S, const Epi& E) {
    const int tid = threadIdx.x, wid = __builtin_amdgcn_readfirstlane(tid >> 6), lane = tid & 63, wr = wid >> 2, wc = wid & 3, fr = lane & 15, fq = lane >> 4;
    const int K = g.K, nt = K / BK;
    unsigned voffA[2], voffB[2];
#pragma unroll
    for (int i = 0; i < 2; ++i) { int R, C; stage_rc(tid * 16 + i * 8192, R, C); const int Rb = Epi::PERM ? ((R & ~31) + perm32(R & 31)) : R;
        voffA[i] = (unsigned)(R * K + C) * 2u; voffB[i] = (unsigned)(Rb * K + C) * 2u; }
    const size_t kstep = (size_t)(BK * 2);
    const size_t hstep = (size_t)HALF * K * 2;
    const size_t tstep = 2 * hstep;
    const unsigned ldsw = (unsigned)wid * 1024u;
    const int aoff = lds_byte(wr * 64 + fr, fq * 8), boff = lds_byte(wc * 32 + fr, fq * 8);
#define PG8_SA(b, h) (((b) * 2 + (h)) * HTB)
#define PG8_SB(b, h) ((4 + (b) * 2 + (h)) * HTB)
#define PG8_STAGE(bufoff, gbase, voff) do { _Pragma("unroll") for (int _i = 0; _i < 2; ++_i) \
        __builtin_amdgcn_global_load_lds((const unsigned*)((const char*)(gbase) + (voff)[_i]), (PG8_LAS unsigned*)(lds + (bufoff) + ldsw + _i * 8192), 16, 0, 0); } while (0)
#define PG8_LDA(dst, b, h) do { _Pragma("unroll") for (int m = 0; m < 4; ++m) _Pragma("unroll") for (int k = 0; k < 2; ++k) dst[m][k] = *(const PG8_LAS bf16x8*)(lds + PG8_SA(b, h) + aoff + m * 2048 + k * 1024); } while (0)
#define PG8_LDB(dst, b, h) do { _Pragma("unroll") for (int n = 0; n < 2; ++n) _Pragma("unroll") for (int k = 0; k < 2; ++k) dst[n][k] = *(const PG8_LAS bf16x8*)(lds + PG8_SB(b, h) + boff + n * 2048 + k * 1024); } while (0)
#define PG8_MMA(ai, bj, At, Bt) do { __builtin_amdgcn_s_setprio(1); _Pragma("unroll") for (int m = 0; m < 4; ++m) _Pragma("unroll") for (int n = 0; n < 2; ++n) _Pragma("unroll") for (int k = 0; k < 2; ++k) \
        acc[ai][bj][m][n] = __builtin_amdgcn_mfma_f32_16x16x32_bf16(Bt[n][k], At[m][k], acc[ai][bj][m][n], 0, 0, 0); __builtin_amdgcn_s_setprio(0); } while (0)
#define PG8_WAIT_V(n) asm volatile("s_waitcnt vmcnt(" #n ")" ::: "memory")
#define PG8_WAIT_L(n) asm volatile("s_waitcnt lgkmcnt(" #n ")" ::: "memory")
#define PG8_BAR __builtin_amdgcn_s_barrier()
#define PG8_SCHED __builtin_amdgcn_sched_barrier(0)
    Unit cur, nxt; int ui = 0;
    if (!S.next(0, cur)) return;
    f32x4 acc[2][2][4][2];
#pragma unroll
    for (int a = 0; a < 2; ++a)
#pragma unroll
        for (int b = 0; b < 2; ++b)
#pragma unroll
            for (int m = 0; m < 4; ++m)
#pragma unroll
                for (int n = 0; n < 2; ++n) acc[a][b][m][n] = (f32x4){0.f, 0.f, 0.f, 0.f};
    bf16x8 At[4][2], B0[2][2], B1[2][2];
    const char* cA = (const char*)g.A + (size_t)cur.pm * tstep; const char* cB = (const char*)g.Bt + (size_t)cur.pn * tstep;
    S.a_ready(cur);
    if constexpr (SP2) {
        PG8_STAGE(PG8_SB(0, 0), cB, voffB); PG8_STAGE(PG8_SB(0, 1), cB + hstep, voffB); PG8_STAGE(PG8_SA(0, 0), cA, voffA); PG8_STAGE(PG8_SA(0, 1), cA + hstep, voffA);
        if (wr == 1) PG8_BAR;
        PG8_WAIT_V(2); PG8_BAR;
        PG8_STAGE(PG8_SB(1, 0), cB + kstep, voffB); PG8_STAGE(PG8_SA(1, 0), cA + kstep, voffA); PG8_STAGE(PG8_SB(1, 1), cB + hstep + kstep, voffB);
        PG8_WAIT_V(6); PG8_BAR;
    } else {
        PG8_STAGE(PG8_SB(0, 0), cB, voffB); PG8_STAGE(PG8_SA(0, 0), cA, voffA); PG8_STAGE(PG8_SB(0, 1), cB + hstep, voffB); PG8_STAGE(PG8_SA(0, 1), cA + hstep, voffA);
        if (wr == 1) PG8_BAR;
        PG8_WAIT_V(4); PG8_BAR;
        PG8_STAGE(PG8_SB(1, 0), cB + kstep, voffB); PG8_STAGE(PG8_SA(1, 0), cA + kstep, voffA); PG8_STAGE(PG8_SB(1, 1), cB + hstep + kstep, voffB);
        PG8_WAIT_V(6); PG8_BAR;
    }
    for (;;) {
        const bool has_next = S.next(ui + 1, nxt);
        const char* nA = has_next ? (const char*)g.A + (size_t)nxt.pm * tstep : cA; const char* nB = has_next ? (const char*)g.Bt + (size_t)nxt.pn * tstep : cB;
        for (int t = 0; t < nt; t += 2) {
            const bool last = (t == nt - 2);
            const char* a1 = cA + (size_t)(t + 1) * kstep;
            const char* a2 = last ? nA : cA + (size_t)(t + 2) * kstep; const char* b2 = last ? nB : cB + (size_t)(t + 2) * kstep;
            const char* a3 = a2 + kstep; const char* b3 = b2 + kstep;
            if (last && has_next) S.a_ready(nxt);
            if constexpr (SP2) {
            PG8_LDB(B0, 0, 0); PG8_LDB(B1, 0, 1); PG8_SCHED; PG8_LDA(At, 0, 0); PG8_STAGE(PG8_SA(1, 1), a1 + hstep, voffA);
            PG8_WAIT_V(8); PG8_WAIT_L(0); PG8_BAR; PG8_MMA(0, 0, At, B0); PG8_MMA(0, 1, At, B1); PG8_BAR; PG8_SCHED;
            PG8_LDA(At, 0, 1); PG8_STAGE(PG8_SB(0, 0), b2, voffB); PG8_STAGE(PG8_SB(0, 1), b2 + hstep, voffB); PG8_STAGE(PG8_SA(0, 0), a2, voffA);
            PG8_WAIT_V(8); PG8_WAIT_L(0); PG8_BAR; PG8_MMA(1, 0, At, B0); PG8_MMA(1, 1, At, B1); PG8_BAR; PG8_SCHED;
            PG8_LDB(B0, 1, 0); PG8_LDB(B1, 1, 1); PG8_SCHED; PG8_LDA(At, 1, 0); PG8_STAGE(PG8_SA(0, 1), a2 + hstep, voffA);
            PG8_WAIT_V(8); PG8_WAIT_L(0); PG8_BAR; PG8_MMA(0, 0, At, B0); PG8_MMA(0, 1, At, B1); PG8_BAR; PG8_SCHED;
            PG8_LDA(At, 1, 1); PG8_STAGE(PG8_SB(1, 0), b3, voffB); PG8_STAGE(PG8_SB(1, 1), b3 + hstep, voffB); PG8_STAGE(PG8_SA(1, 0), a3, voffA);
            PG8_WAIT_V(8); PG8_WAIT_L(0); PG8_BAR; PG8_MMA(1, 0, At, B0); PG8_MMA(1, 1, At, B1); PG8_BAR; PG8_SCHED;
            } else {
            PG8_LDB(B0, 0, 0); PG8_SCHED; PG8_LDA(At, 0, 0); PG8_STAGE(PG8_SA(1, 1), a1 + hstep, voffA);
            PG8_WAIT_L(8); PG8_BAR; PG8_WAIT_L(0); PG8_MMA(0, 0, At, B0); PG8_BAR; PG8_SCHED;
            PG8_LDB(B1, 0, 1); PG8_STAGE(PG8_SB(0, 0), b2, voffB);
            PG8_BAR; PG8_WAIT_L(0); PG8_MMA(0, 1, At, B1); PG8_BAR;
            PG8_LDA(At, 0, 1); PG8_STAGE(PG8_SA(0, 0), a2, voffA);
            PG8_BAR; PG8_WAIT_L(0); PG8_MMA(1, 0, At, B0); PG8_BAR; PG8_SCHED;
            PG8_STAGE(PG8_SB(0, 1), b2 + hstep, voffB);
            PG8_WAIT_V(6); PG8_BAR; PG8_MMA(1, 1, At, B1); PG8_BAR;
            PG8_LDB(B0, 1, 0); PG8_SCHED; PG8_LDA(At, 1, 0); PG8_STAGE(PG8_SA(0, 1), a2 + hstep, voffA);
            PG8_WAIT_L(8); PG8_BAR; PG8_WAIT_L(0); PG8_MMA(0, 0, At, B0); PG8_BAR; PG8_SCHED;
            PG8_LDB(B1, 1, 1); PG8_STAGE(PG8_SB(1, 0), b3, voffB);
            PG8_BAR; PG8_WAIT_L(0); PG8_MMA(0, 1, At, B1); PG8_BAR;
            PG8_LDA(At, 1, 1); PG8_STAGE(PG8_SA(1, 0), a3, voffA);
            PG8_BAR; PG8_WAIT_L(0); PG8_MMA(1, 0, At, B0); PG8_BAR; PG8_SCHED;
            PG8_STAGE(PG8_SB(1, 1), b3 + hstep, voffB);
            PG8_WAIT_V(6); PG8_BAR; PG8_MMA(1, 1, At, B1); PG8_BAR;
            }
        }
        if constexpr (ALIGN_EPI) { if (wr == 0) PG8_BAR; }
        if constexpr (!Epi::AFTER_DRAIN) { E(acc, cur, wr, wc, fr, fq); S.done(cur); }
        if (!has_next) break;
#pragma unroll
        for (int a = 0; a < 2; ++a)
#pragma unroll
            for (int b = 0; b < 2; ++b)
#pragma unroll
                for (int m = 0; m < 4; ++m)
#pragma unroll
                    for (int n = 0; n < 2; ++n) acc[a][b][m][n] = (f32x4){0.f, 0.f, 0.f, 0.f};
        cur = nxt; cA = nA; cB = nB; ++ui;
        if constexpr (ALIGN_EPI) { if (wr == 1) PG8_BAR; }
    }
    PG8_WAIT_V(0);
    if constexpr (!ALIGN_EPI) { if (wr == 0) PG8_BAR; }
    PG8_BAR;
    if constexpr (Epi::AFTER_DRAIN) { E.fused(acc, cur, wr, wc, fr, fq, lds, wid, lane); S.done(cur); }
#undef PG8_SA
#undef PG8_SB
#undef PG8_STAGE
#undef PG8_LDA
#undef PG8_LDB
#undef PG8_MMA
#undef PG8_WAIT_V
#undef PG8_WAIT_L
#undef PG8_BAR
#undef PG8_SCHED
}
}
namespace attn {
using bf16 = __hip_bfloat16;
constexpr int   D = 128, NW = 8, QBLK = 32, KVBLK = 64;
constexpr float SCALE = 0.088388347648318440f;
constexpr float THR = 8.f;
constexpr int SDEPTH = 2;
constexpr int LDQ = 1024, LDK = 256, LDO = 1024;
constexpr size_t SHM_V = KVBLK * D * 2, SHM_K = KVBLK * D * 2, SHM_ATTN = 2 * SHM_V + 2 * SHM_K + NW * 64 * 4;
using bf16x8 = __attribute__((ext_vector_type(8))) short;
using s16x4  = __attribute__((ext_vector_type(4))) short;
using f32x16 = __attribute__((ext_vector_type(16))) float;
using f32x8  = __attribute__((ext_vector_type(8))) float;
using u32x4  = __attribute__((ext_vector_type(4))) unsigned;
#define KSWZ(row, colB) ((row) * 256 + ((colB) ^ (((row) & 7) << 4)))
#define SBAR() __builtin_amdgcn_sched_barrier(0)
__device__ __forceinline__ int crow(int r, int hi) { return (r & 3) + 8 * (r >> 2) + 4 * hi; }
__device__ __forceinline__ unsigned cvtpk(float lo, float hi) {
  unsigned r; asm volatile("v_cvt_pk_bf16_f32 %0, %1, %2" : "=v"(r) : "v"(lo), "v"(hi)); return r;
}
template <typename TIn> struct Stage;
template <> struct Stage<bf16>  { using T = bf16x8;
  __device__ static __forceinline__ T ld8(const bf16* p) { return *reinterpret_cast<const bf16x8*>(p); }
  __device__ static __forceinline__ bf16x8 tobf(T x) { return x; } };
template <> struct Stage<float> { using T = f32x8;
  __device__ static __forceinline__ T ld8(const float* p) { return *reinterpret_cast<const f32x8*>(p); }
  __device__ static __forceinline__ bf16x8 tobf(T x) {
    u32x4 w = {cvtpk(x[0], x[1]), cvtpk(x[2], x[3]), cvtpk(x[4], x[5]), cvtpk(x[6], x[7])}; return *reinterpret_cast<bf16x8*>(&w); } };

__device__ __forceinline__ void partialSM(f32x16& p0, f32x16& p1, float& m_reg, float& mn, float& alpha) {
  constexpr float C = SCALE * 1.4426950408889634f;
  float pmax = p0[0]; for (int r = 1; r < 16; ++r) pmax = fmaxf(pmax, p0[r]); for (int r = 0; r < 16; ++r) pmax = fmaxf(pmax, p1[r]);
  { auto rr = __builtin_amdgcn_permlane32_swap(__float_as_uint(pmax), __float_as_uint(pmax), false, false);
    pmax = fmaxf(__uint_as_float(rr[0]), __uint_as_float(rr[1])); }
  if (__builtin_expect(__all(pmax - m_reg <= THR / SCALE), 1)) { mn = m_reg; alpha = 1.f; }
  else { mn = fmaxf(m_reg, pmax); alpha = __builtin_amdgcn_exp2f((m_reg - mn) * C); m_reg = mn; }
  float mnC = -mn * C;
  for (int r = 0; r < 16; ++r) p0[r] = fmaf(p0[r], C, mnC); for (int r = 0; r < 16; ++r) p1[r] = fmaf(p1[r], C, mnC);
  for (int r = 0; r < 16; ++r) p0[r] = __builtin_amdgcn_exp2f(p0[r]);
}
__device__ __forceinline__ void finishSM(f32x16& p0, f32x16& p1, float alpha, float& l_reg, bf16x8& pa0, bf16x8& pa1, bf16x8& pa2, bf16x8& pa3) {
  for (int r = 0; r < 16; ++r) p1[r] = __builtin_amdgcn_exp2f(p1[r]);
  float ps = 0; for (int r = 0; r < 16; ++r) ps += p0[r]; for (int r = 0; r < 16; ++r) ps += p1[r];
  { auto rr = __builtin_amdgcn_permlane32_swap(__float_as_uint(ps), __float_as_uint(ps), false, false);
    ps = __uint_as_float(rr[0]) + __uint_as_float(rr[1]); }
  l_reg = l_reg * alpha + ps;
#define PK4(P, BASE, OUT) do { unsigned a0 = cvtpk(P[BASE + 0], P[BASE + 1]), a1 = cvtpk(P[BASE + 2], P[BASE + 3]);   \
    unsigned b0 = cvtpk(P[BASE + 4], P[BASE + 5]), b1 = cvtpk(P[BASE + 6], P[BASE + 7]);                              \
    auto r0 = __builtin_amdgcn_permlane32_swap(a0, b0, false, false); auto r1 = __builtin_amdgcn_permlane32_swap(a1, b1, false, false); \
    u32x4 w = {r0[0], r1[0], r0[1], r1[1]}; OUT = *reinterpret_cast<bf16x8*>(&w); } while (0)
  PK4(p0, 0, pa0); PK4(p0, 8, pa1); PK4(p1, 0, pa2); PK4(p1, 8, pa3);
#undef PK4
}
__device__ __forceinline__ void qkt(f32x16& p0, f32x16& p1, const bf16* Ks, const bf16x8* qr, int r32, int hi) {
  p0 = f32x16{}; p1 = f32x16{};
  for (int d0 = 0; d0 < 8; ++d0) { int cb = (d0 * 16 + hi * 8) * 2;
    bf16x8 b0 = *reinterpret_cast<const bf16x8*>((const char*)Ks + KSWZ(r32, cb));
    bf16x8 b1 = *reinterpret_cast<const bf16x8*>((const char*)Ks + KSWZ(32 + r32, cb));
    p0 = __builtin_amdgcn_mfma_f32_32x32x16_bf16(b0, qr[d0], p0, 0, 0, 0);
    p1 = __builtin_amdgcn_mfma_f32_32x32x16_bf16(b1, qr[d0], p1, 0, 0, 0); }
}
__device__ __forceinline__ int v_st(int k, int c) { const int kk = (k & ~0xC) | ((k & 4) << 1) | ((k & 8) >> 1); return ((kk >> 3) * 4 + (c >> 5)) * 512 + ((kk & 7) * 32 + (c & 31)) * 2; }
__device__ __forceinline__ int v_rd_base(int lane) { return ((lane & 3) << 3) | (((lane >> 2) & 3) << 6) | (((lane >> 4) & 1) << 5) | (((lane >> 5) & 1) << 8); }
constexpr int v_rd_off(int d0, int ks, int half) { return d0 * 512 + ks * 4096 + half * 2048; }
template <int OFF> __device__ __forceinline__ s16x4 tr_read(int vb) {
  s16x4 r; asm volatile("ds_read_b64_tr_b16 %0, %1 offset:%2" : "=&v"(r) : "v"(vb), "i"(OFF) : "memory"); return r;
}
template <int D0> __device__ __forceinline__ void pv_one(f32x16& od, int vb, bf16x8 pa0, bf16x8 pa1, bf16x8 pa2, bf16x8 pa3) {
  const s16x4 l0 = tr_read<v_rd_off(D0, 0, 0)>(vb), h0 = tr_read<v_rd_off(D0, 0, 1)>(vb), l1 = tr_read<v_rd_off(D0, 1, 0)>(vb), h1 = tr_read<v_rd_off(D0, 1, 1)>(vb);
  const s16x4 l2 = tr_read<v_rd_off(D0, 2, 0)>(vb), h2 = tr_read<v_rd_off(D0, 2, 1)>(vb), l3 = tr_read<v_rd_off(D0, 3, 0)>(vb), h3 = tr_read<v_rd_off(D0, 3, 1)>(vb);
  asm volatile("s_waitcnt lgkmcnt(0)" ::: "memory"); SBAR();
#define PK(L, H) (bf16x8){L[0], L[1], L[2], L[3], H[0], H[1], H[2], H[3]}
  od = __builtin_amdgcn_mfma_f32_32x32x16_bf16(pa0, PK(l0, h0), od, 0, 0, 0);
  od = __builtin_amdgcn_mfma_f32_32x32x16_bf16(pa1, PK(l1, h1), od, 0, 0, 0);
  od = __builtin_amdgcn_mfma_f32_32x32x16_bf16(pa2, PK(l2, h2), od, 0, 0, 0);
  od = __builtin_amdgcn_mfma_f32_32x32x16_bf16(pa3, PK(l3, h3), od, 0, 0, 0);
#undef PK
}
__device__ __forceinline__ void pv_d0(f32x16* o, int vb, bf16x8 pa0, bf16x8 pa1, bf16x8 pa2, bf16x8 pa3) {
  pv_one<0>(o[0], vb, pa0, pa1, pa2, pa3); pv_one<1>(o[1], vb, pa0, pa1, pa2, pa3); pv_one<2>(o[2], vb, pa0, pa1, pa2, pa3); pv_one<3>(o[3], vb, pa0, pa1, pa2, pa3);
}

template <typename TQ>
__device__ __forceinline__ void attn_dense_body(const TQ* __restrict__ Qb, const bf16* __restrict__ Kh, const bf16* __restrict__ Vh,
                                                bf16* __restrict__ Ob, int seq, char* lds) {
  using St = Stage<bf16>; using SQ = Stage<TQ>;
  const int tid = threadIdx.x, wid = tid >> 6, lane = tid & 63, r32 = lane & 31, hi = lane >> 5;
  bf16* V_lds = (bf16*)lds; bf16* K_lds = (bf16*)(lds + 2 * SHM_V);
  float* ws = (float*)(lds + 2 * SHM_V + 2 * SHM_K) + wid * 64; float* li_l = ws; float* al_l = ws + 32;
  float m_reg = -1e30f, l_reg = 0; f32x16 o[4] = {}; bf16x8 qr[8];
  const TQ* Qw = Qb + (long)(wid * QBLK + r32) * LDQ + hi * 8;
#pragma unroll
  for (int d0 = 0; d0 < 8; ++d0) qr[d0] = SQ::tobf(SQ::ld8(Qw + d0 * 16));
  const int sr = tid >> 4, sc = (tid & 15) * 8, vst0 = v_st(sr, sc), vst1 = v_st(32 + sr, sc);
  const int vb0 = (int)(uintptr_t)V_lds + v_rd_base(lane);
  struct { typename St::T vs0, vs1, ks0, ks1; } sr_[SDEPTH];
#define SLOAD(i, k0) do { sr_[i].vs0 = St::ld8(&Vh[(long)((k0) + sr) * LDK + sc]); sr_[i].vs1 = St::ld8(&Vh[(long)((k0) + 32 + sr) * LDK + sc]); \
    sr_[i].ks0 = St::ld8(&Kh[(long)((k0) + sr) * LDK + sc]); sr_[i].ks1 = St::ld8(&Kh[(long)((k0) + 32 + sr) * LDK + sc]); } while (0)
#define SWRITE(b, i) do { *(bf16x8*)((char*)V_lds + (b) * SHM_V + vst0) = St::tobf(sr_[i].vs0);          \
    *(bf16x8*)((char*)V_lds + (b) * SHM_V + vst1) = St::tobf(sr_[i].vs1); int kc = sc * 2;               \
    *(bf16x8*)((char*)K_lds + (b) * SHM_K + KSWZ(sr, kc)) = St::tobf(sr_[i].ks0);                       \
    *(bf16x8*)((char*)K_lds + (b) * SHM_K + KSWZ(32 + sr, kc)) = St::tobf(sr_[i].ks1); } while (0)
#define SWAIT() do { if constexpr (SDEPTH == 2) asm volatile("s_waitcnt vmcnt(4)" ::: "memory"); else asm volatile("s_waitcnt vmcnt(0)" ::: "memory"); } while (0)
#define RESC(a) do { if (__any((a) < 1.f)) { if (hi == 0) al_l[r32] = (a); asm volatile("s_waitcnt lgkmcnt(0)" ::: "memory"); \
    for (int d = 0; d < 4; ++d) for (int r = 0; r < 16; ++r) o[d][r] *= al_l[crow(r, hi)]; } } while (0)
  f32x16 pA0, pA1, pB0, pB1; float mnA, mnB, alA, alB; bf16x8 pa0, pa1, pa2, pa3; const int NT = seq / KVBLK;
  constexpr int SE = 0, SO = SDEPTH - 1;
  SLOAD(SE, 0); asm volatile("s_waitcnt vmcnt(0)" ::: "memory"); SWRITE(0, SE); __syncthreads();
  qkt(pA0, pA1, K_lds, qr, r32, hi); partialSM(pA0, pA1, m_reg, mnA, alA);
  SLOAD(SO, KVBLK); if constexpr (SDEPTH == 2) { if (2 < NT) SLOAD(SE, 2 * KVBLK); }
  SWAIT(); SWRITE(1, SO); __syncthreads();
  for (int j = 1; j + 1 < NT; j += 2) {
    SBAR(); qkt(pB0, pB1, (bf16*)((char*)K_lds + SHM_K), qr, r32, hi);
    finishSM(pA0, pA1, alA, l_reg, pa0, pa1, pa2, pa3); SBAR();
    SLOAD(SO, (j + SDEPTH) * KVBLK); SBAR();
    pv_d0(o, vb0, pa0, pa1, pa2, pa3); partialSM(pB0, pB1, m_reg, mnB, alB);
    __syncthreads(); SWAIT(); SWRITE(0, SE);
    RESC(alB); __syncthreads();
    SBAR(); qkt(pA0, pA1, K_lds, qr, r32, hi);
    finishSM(pB0, pB1, alB, l_reg, pa0, pa1, pa2, pa3); SBAR();
    if (SDEPTH == 1 || j + 3 < NT) SLOAD(SE, (j + 1 + SDEPTH) * KVBLK); SBAR();
    pv_d0(o, vb0 + (int)SHM_V, pa0, pa1, pa2, pa3); partialSM(pA0, pA1, m_reg, mnA, alA);
    __syncthreads(); SWAIT(); SWRITE(1, SO);
    RESC(alA); __syncthreads();
  }
  SBAR(); qkt(pB0, pB1, (bf16*)((char*)K_lds + SHM_K), qr, r32, hi);
  finishSM(pA0, pA1, alA, l_reg, pa0, pa1, pa2, pa3); SBAR();
  pv_d0(o, vb0, pa0, pa1, pa2, pa3); partialSM(pB0, pB1, m_reg, mnB, alB);
  __syncthreads(); RESC(alB);
  finishSM(pB0, pB1, alB, l_reg, pa0, pa1, pa2, pa3); SBAR();
  pv_d0(o, vb0 + (int)SHM_V, pa0, pa1, pa2, pa3);
  if (hi == 0) li_l[r32] = l_reg; asm volatile("s_waitcnt lgkmcnt(0)" ::: "memory");
  float rli[16];
#pragma unroll
  for (int r = 0; r < 16; ++r) rli[r] = __builtin_amdgcn_rcpf(li_l[crow(r, hi)]);
  bf16* Ow = Ob + (long)(wid * QBLK) * LDO;
#pragma unroll
  for (int r = 0; r < 16; ++r) { int orow = crow(r, hi);
#pragma unroll
    for (int d0 = 0; d0 < 4; ++d0) Ow[(long)orow * LDO + d0 * 32 + r32] = __float2bfloat16(o[d0][r] * rli[r]); }
#undef SLOAD
#undef SWRITE
#undef SWAIT
#undef RESC
}
#undef KSWZ
#undef SBAR
}
#ifndef DUP_PHASE
#define DUP_PHASE -1
#endif
#ifndef MK_MULTI
#define MK_MULTI 0
#endif
constexpr int NWAVES = 8, NTHR = 512;
constexpr int BATCH = 32, SEQ = 2048, DM = 1024, CTXL = 256, DFF = 4096, NIN = 4096;
constexpr int MLAT = BATCH * SEQ;
constexpr int MCTX = BATCH * CTXL;
constexpr int MALL = MLAT + MCTX;
constexpr int NMOD = 6 * DM;
constexpr float EPS = 1e-6f;
constexpr size_t MiB = 1u << 20;
constexpr size_t WS_MOD = 0;
constexpr size_t WS_COS = 1 * MiB, WS_SIN = WS_COS + 8192;
constexpr size_t WS_WIN = 2 * MiB, WS_WAU = 10 * MiB, WS_WPU = 12 * MiB, WS_WGB = 13 * MiB, WS_WOUT = 14 * MiB, WS_WF1 = 16 * MiB, WS_WF2 = 24 * MiB;
constexpr size_t WS_XN = 32 * MiB;
constexpr size_t WS_AO = WS_XN;
constexpr size_t WS_Q = 176 * MiB;
constexpr size_t WS_T = WS_Q;
constexpr size_t WS_K = 304 * MiB, WS_V = 340 * MiB;
constexpr size_t WS_PI = 376 * MiB;
constexpr size_t WS_MIX = WS_PI;
constexpr size_t WS_PLD = 440 * MiB;
constexpr size_t WS_GT = 504 * MiB;
constexpr size_t WS_Y = WS_GT;
constexpr size_t WS_MB = 760 * MiB;
constexpr size_t WS_XN2 = WS_MB;
constexpr size_t WS_F = 32 * MiB;
constexpr size_t WS_Z = 544 * MiB;
constexpr size_t WS_END = 888 * MiB;
constexpr int RING_BYTES = 131072, EXCH_OFF = RING_BYTES, LDS_BYTES = 147456;

#define GAS __attribute__((address_space(1)))
#define LAS __attribute__((address_space(3)))
typedef unsigned short bf16;
typedef unsigned v4u __attribute__((ext_vector_type(4)));
typedef float f32x4 __attribute__((ext_vector_type(4)));
#define LDS_WAIT() asm volatile("s_waitcnt lgkmcnt(0)" ::: "memory")
__device__ __forceinline__ unsigned f2bf(float f) { unsigned u = __builtin_bit_cast(unsigned, f); return (u + 0x7fffu + ((u >> 16) & 1u)) >> 16; }
__device__ __forceinline__ unsigned pk2(float lo, float hi) { return f2bf(lo) | (f2bf(hi) << 16); }
__device__ __forceinline__ float bfl(unsigned u) { return __uint_as_float(u << 16); }
__device__ __forceinline__ float bfh(unsigned u) { return __uint_as_float(u & 0xffff0000u); }
__device__ __forceinline__ float wave_sum(float v) {
#pragma unroll
    for (int o = 1; o < 64; o <<= 1) v += __shfl_xor(v, o);
    return v;
}
__device__ __forceinline__ int perm7(int d) { return (d & 0x43) | ((d & 0x10) << 1) | ((d & 0x0C) << 1) | ((d & 0x20) >> 3); }

struct Frame {
    LAS unsigned char* lds;
    int tid, lane, wave, vcu, G;
    const float* in[21]; float* out; unsigned char* ws;
};
template <bool QKPERM>
__device__ __forceinline__ void p0_transpose_item(const float* W, int K, int N, bf16* WT, LAS float* scr, int item, int lane) {
    const int nblk = N / 32, kb = item / nblk, nb = item % nblk, k0 = 64 * kb, n0 = 32 * nb;
#pragma unroll 8
    for (int i = 0; i < 32; ++i) { const int kk = 2 * i + (lane >> 5); scr[kk * 33 + (lane & 31)] = W[(size_t)(k0 + kk) * N + n0 + (lane & 31)]; }
    LDS_WAIT(); asm volatile("" ::: "memory");
    const int c = lane & 7;
#pragma unroll
    for (int j = 0; j < 4; ++j) { const int n = (lane >> 3) + 8 * j; const LAS float* s = scr + (8 * c) * 33 + n;
        v4u o; o.x = pk2(s[0 * 33], s[1 * 33]); o.y = pk2(s[2 * 33], s[3 * 33]); o.z = pk2(s[4 * 33], s[5 * 33]); o.w = pk2(s[6 * 33], s[7 * 33]);
        int row = n0 + n; if (QKPERM && row < 1280) row = (row & ~127) | perm7(row & 127);
        *(GAS v4u*)(WT + (size_t)row * K + k0 + 8 * c) = o; }
    LDS_WAIT(); asm volatile("" ::: "memory");
}
__device__ __forceinline__ void mod_unit(Frame& F, int u) {
    LAS float* sc = (LAS float*)F.lds;
    LAS float* red = (LAS float*)(F.lds + 73728);
    const float* c = F.in[1]; const float* cctx = F.in[3]; const float* wmod = F.in[4]; const float* bmod = F.in[5];
    float* MOD = (float*)(F.ws + WS_MOD);
    const int col = F.tid & 31, ks = F.tid >> 5, n0 = 32 * u;
    float acc[33];
#pragma unroll
    for (int r = 0; r < 33; ++r) acc[r] = 0.f;
    for (int half = 0; half < 2; ++half) {
        __syncthreads();
        for (int idx = F.tid; idx < 512 * 36; idx += NTHR) { const int k = idx / 36, r = idx - k * 36, kk = half * 512 + k;
            float v = 0.f; if (r < 32) v = c[r * DM + kk]; else if (r == 32) v = cctx[kk];
            sc[idx] = v / (1.0f + __expf(-v)); }
        __syncthreads();
        for (int i = 0; i < 32; ++i) { const int k = ks * 32 + i; const float w = wmod[(size_t)(half * 512 + k) * NMOD + n0 + col];
#pragma unroll
            for (int r4 = 0; r4 < 8; ++r4) { const f32x4 s = *(const LAS f32x4*)(sc + k * 36 + 4 * r4);
                acc[4 * r4 + 0] += s[0] * w; acc[4 * r4 + 1] += s[1] * w; acc[4 * r4 + 2] += s[2] * w; acc[4 * r4 + 3] += s[3] * w; }
            acc[32] += sc[k * 36 + 32] * w; }
    }
#pragma unroll
    for (int r = 0; r < 33; ++r) red[(ks * 33 + r) * 32 + col] = acc[r];
    __syncthreads();
    for (int idx = F.tid; idx < 33 * 32; idx += NTHR) { const int r = idx >> 5, cc = idx & 31; float s = 0.f;
#pragma unroll
        for (int k = 0; k < 16; ++k) s += red[(k * 33 + r) * 32 + cc];
        MOD[r * NMOD + n0 + cc] = s + bmod[n0 + cc]; }
    __syncthreads();
}
__device__ __forceinline__ void p0_prologue(Frame& F) {
    for (int u = blockIdx.x; u < NMOD / 32; u += F.G) mod_unit(F, u);
    __syncthreads();
    LAS float* scr = (LAS float*)(F.lds + F.wave * 16384);
    const int gw = F.vcu * NWAVES + F.wave, NGW = F.G * NWAVES;
    constexpr int I_IN = (DM / 64) * (NIN / 32), I_AU = (DM / 64) * (DM / 32), I_PU = (512 / 64) * (DM / 32), I_OUT = I_AU, I_F1 = (DM / 64) * (DFF / 32), I_F2 = (DFF / 64) * (DM / 32);
    constexpr int NITEMS = I_IN + I_AU + I_PU + I_OUT + I_F1 + I_F2;
    for (int it = gw; it < NITEMS; it += NGW) {
        int r = it;
        if (r < I_IN) { p0_transpose_item<true>(F.in[10], DM, NIN, (bf16*)(F.ws + WS_WIN), scr, r, F.lane); continue; } r -= I_IN;
        if (r < I_AU) { p0_transpose_item<false>(F.in[14], DM, DM, (bf16*)(F.ws + WS_WAU), scr, r, F.lane); continue; } r -= I_AU;
        if (r < I_PU) { p0_transpose_item<false>(F.in[17], 512, DM, (bf16*)(F.ws + WS_WPU), scr, r, F.lane); continue; } r -= I_PU;
        if (r < I_OUT) { p0_transpose_item<false>(F.in[18], DM, DM, (bf16*)(F.ws + WS_WOUT), scr, r, F.lane); continue; } r -= I_OUT;
        if (r < I_F1) { p0_transpose_item<false>(F.in[19], DM, DFF, (bf16*)(F.ws + WS_WF1), scr, r, F.lane); continue; } r -= I_F1;
        p0_transpose_item<false>(F.in[20], DFF, DM, (bf16*)(F.ws + WS_WF2), scr, r, F.lane);
    }
    { const float* wg = F.in[15]; bf16* WG = (bf16*)(F.ws + WS_WGB); const int gt = blockIdx.x * NTHR + F.tid, NT = F.G * NTHR;
      for (int idx = gt; idx < 512 * 512; idx += NT) { const int n = idx >> 9, k = idx & 511, g = n >> 7;
          WG[idx] = ((k >> 7) == g) ? (bf16)f2bf(wg[(size_t)(g * 128 + (k & 127)) * 128 + (n & 127)]) : (bf16)0; }
      float* cosT = (float*)(F.ws + WS_COS); float* sinT = (float*)(F.ws + WS_SIN);
      if (gt < 2048) { const int pos = gt >> 5, j = gt & 31; const float fr = powf(10000.0f, -(float)j / 32.0f), ang = (float)pos * fr; cosT[gt] = cosf(ang); sinT[gt] = sinf(ang); } }
}
__device__ __forceinline__ void p1_rows(Frame& F) {
    const int gw = F.vcu * NWAVES + F.wave, NGW = F.G * NWAVES;
    const float* MOD = (const float*)(F.ws + WS_MOD); const float* g = F.in[6]; bf16* XN = (bf16*)(F.ws + WS_XN);
    f32x4 gv[4];
#pragma unroll
    for (int j = 0; j < 4; ++j) gv[j] = *((const f32x4*)g + F.lane + 64 * j);
    for (int m0 = 2 * gw; m0 < MALL; m0 += 2 * NGW) {
        f32x4 v[2][4]; float s[2] = {0.f, 0.f};
#pragma unroll
        for (int rr = 0; rr < 2; ++rr) { const int m = m0 + rr;
            const float* src = m < MLAT ? F.in[0] + (size_t)m * DM : F.in[2] + (size_t)(m - MLAT) * DM;
            const f32x4* xr = (const f32x4*)src + F.lane;
#pragma unroll
            for (int j = 0; j < 4; ++j) v[rr][j] = xr[64 * j]; }
#pragma unroll
        for (int rr = 0; rr < 2; ++rr)
#pragma unroll
            for (int j = 0; j < 4; ++j) s[rr] += (v[rr][j].x * v[rr][j].x + v[rr][j].y * v[rr][j].y) + (v[rr][j].z * v[rr][j].z + v[rr][j].w * v[rr][j].w);
#pragma unroll
        for (int rr = 0; rr < 2; ++rr) { const int m = m0 + rr;
            const float* mr = MOD + (size_t)(m < MLAT ? (m >> 11) : 32) * NMOD;
            const float rstd = rsqrtf(wave_sum(s[rr]) * (1.f / DM) + EPS);
            unsigned long long* o8 = (unsigned long long*)(XN + (size_t)m * DM) + F.lane;
#pragma unroll
            for (int j = 0; j < 4; ++j) { const f32x4 sh = *((const f32x4*)mr + F.lane + 64 * j), sc = *((const f32x4*)(mr + DM) + F.lane + 64 * j);
                const f32x4 h = (v[rr][j] * rstd * gv[j]) * (sc + 1.0f) + sh;
                o8[64 * j] = (unsigned long long)pk2(h.x, h.y) | ((unsigned long long)pk2(h.z, h.w) << 32); } }
    }
}
template <int HW>
__device__ __forceinline__ void pool_quad(const bf16* PI, bf16* PL, int row, int col) {
    const int t = row & (SEQ - 1);
    const bf16* base = PI + (size_t)(row - t) * 512 + col;
    v4u w[2 * HW];
#pragma unroll
    for (int i = 0; i < 2 * HW; ++i) { int s = t - HW + i; s = s < 0 ? 0 : (s > SEQ - 1 ? SEQ - 1 : s); w[i] = *(const v4u*)(base + (size_t)s * 512); }
    float a[8];
#pragma unroll
    for (int e = 0; e < 8; ++e) a[e] = 0.f;
#pragma unroll
    for (int i = 0; i < 2 * HW; ++i) { const int s = t - HW + i; const float k = (s >= 0 && s < SEQ) ? 1.f : 0.f;
        a[0] += k * bfl(w[i].x); a[1] += k * bfh(w[i].x); a[2] += k * bfl(w[i].y); a[3] += k * bfh(w[i].y); a[4] += k * bfl(w[i].z); a[5] += k * bfh(w[i].z); a[6] += k * bfl(w[i].w); a[7] += k * bfh(w[i].w); }
    const int lo = t - HW < 0 ? 0 : t - HW, hi = t + HW > SEQ ? SEQ : t + HW;
    const v4u c = w[HW]; const float inv = 1.0f / (float)(hi - lo);
    v4u o; o.x = pk2(a[0] * inv - bfl(c.x), a[1] * inv - bfh(c.x)); o.y = pk2(a[2] * inv - bfl(c.y), a[3] * inv - bfh(c.y));
    o.z = pk2(a[4] * inv - bfl(c.z), a[5] * inv - bfh(c.z)); o.w = pk2(a[6] * inv - bfl(c.w), a[7] * inv - bfh(c.w));
    *(v4u*)(PL + (size_t)row * 512 + col) = o;
}
__device__ __forceinline__ void p3_pool(Frame& F) {
    const bf16* PI = (const bf16*)(F.ws + WS_PI); bf16* PL = (bf16*)(F.ws + WS_PLD);
    const int gw = F.vcu * NWAVES + F.wave, NGW = F.G * NWAVES;
    for (int rq = gw; rq < MLAT / 4; rq += NGW) {
        const int row = rq * 4 + (F.lane >> 4), c8 = (F.lane & 15) * 8;
        pool_quad<1>(PI, PL, row, c8); pool_quad<2>(PI, PL, row, 128 + c8); pool_quad<4>(PI, PL, row, 256 + c8); pool_quad<8>(PI, PL, row, 384 + c8);
    }
}
__device__ __forceinline__ void p7_rows(Frame& F) {
    const int gw = F.vcu * NWAVES + F.wave, NGW = F.G * NWAVES;
    const float* MOD = (const float*)(F.ws + WS_MOD); const float* Y = (const float*)(F.ws + WS_Y); bf16* XN2 = (bf16*)(F.ws + WS_XN2);
    const float* gpo = F.in[7]; const float* gpr = F.in[8];
    for (int m0 = 2 * gw; m0 < MLAT; m0 += 2 * NGW) {
        f32x4 y[2][4], x[2][4]; float s[2] = {0.f, 0.f}, s2[2] = {0.f, 0.f};
#pragma unroll
        for (int rr = 0; rr < 2; ++rr) { const int m = m0 + rr;
            const f32x4* yr = (const f32x4*)(Y + (size_t)m * DM) + F.lane; const f32x4* xr = (const f32x4*)(F.in[0] + (size_t)m * DM) + F.lane;
#pragma unroll
            for (int j = 0; j < 4; ++j) { y[rr][j] = yr[64 * j]; x[rr][j] = xr[64 * j]; } }
#pragma unroll
        for (int rr = 0; rr < 2; ++rr)
#pragma unroll
            for (int j = 0; j < 4; ++j) s[rr] += (y[rr][j].x * y[rr][j].x + y[rr][j].y * y[rr][j].y) + (y[rr][j].z * y[rr][j].z + y[rr][j].w * y[rr][j].w);
        const float* mr = MOD + (size_t)(m0 >> 11) * NMOD;
#pragma unroll
        for (int rr = 0; rr < 2; ++rr) { const int m = m0 + rr;
            const float rstd = rsqrtf(wave_sum(s[rr]) * (1.f / DM) + EPS);
            f32x4* orow = (f32x4*)(F.out + (size_t)m * DM) + F.lane;
#pragma unroll
            for (int j = 0; j < 4; ++j) { const f32x4 ga = *((const f32x4*)(mr + 2 * DM) + F.lane + 64 * j), gg = *((const f32x4*)gpo + F.lane + 64 * j);
                x[rr][j] = x[rr][j] + ga * (y[rr][j] * rstd * gg); orow[64 * j] = x[rr][j];
                s2[rr] += (x[rr][j].x * x[rr][j].x + x[rr][j].y * x[rr][j].y) + (x[rr][j].z * x[rr][j].z + x[rr][j].w * x[rr][j].w); } }
#pragma unroll
        for (int rr = 0; rr < 2; ++rr) { const int m = m0 + rr;
            const float rstd2 = rsqrtf(wave_sum(s2[rr]) * (1.f / DM) + EPS);
            unsigned long long* o8 = (unsigned long long*)(XN2 + (size_t)m * DM) + F.lane;
#pragma unroll
            for (int j = 0; j < 4; ++j) { const f32x4 sh = *((const f32x4*)(mr + 3 * DM) + F.lane + 64 * j), sc = *((const f32x4*)(mr + 4 * DM) + F.lane + 64 * j), gg = *((const f32x4*)gpr + F.lane + 64 * j);
                const f32x4 h = (x[rr][j] * rstd2 * gg) * (sc + 1.0f) + sh;
                o8[64 * j] = (unsigned long long)pk2(h.x, h.y) | ((unsigned long long)pk2(h.z, h.w) << 32); } }
    }
}
__device__ __forceinline__ void p10_rows(Frame& F) {
    const int gw = F.vcu * NWAVES + F.wave, NGW = F.G * NWAVES;
    const float* MOD = (const float*)(F.ws + WS_MOD); const float* Z = (const float*)(F.ws + WS_Z); const float* gpo = F.in[9];
    for (int m0 = 2 * gw; m0 < MLAT; m0 += 2 * NGW) {
        f32x4 z[2][4], x[2][4]; float s[2] = {0.f, 0.f};
#pragma unroll
        for (int rr = 0; rr < 2; ++rr) { const int m = m0 + rr;
            const f32x4* zr = (const f32x4*)(Z + (size_t)m * DM) + F.lane; const f32x4* xr = (const f32x4*)(F.out + (size_t)m * DM) + F.lane;
#pragma unroll
            for (int j = 0; j < 4; ++j) { z[rr][j] = zr[64 * j]; x[rr][j] = xr[64 * j]; } }
#pragma unroll
        for (int rr = 0; rr < 2; ++rr)
#pragma unroll
            for (int j = 0; j < 4; ++j) s[rr] += (z[rr][j].x * z[rr][j].x + z[rr][j].y * z[rr][j].y) + (z[rr][j].z * z[rr][j].z + z[rr][j].w * z[rr][j].w);
        const float* mr = MOD + (size_t)(m0 >> 11) * NMOD;
#pragma unroll
        for (int rr = 0; rr < 2; ++rr) { const int m = m0 + rr;
            const float rstd = rsqrtf(wave_sum(s[rr]) * (1.f / DM) + EPS);
            f32x4* orow = (f32x4*)(F.out + (size_t)m * DM) + F.lane;
#pragma unroll
            for (int j = 0; j < 4; ++j) { const f32x4 ga = *((const f32x4*)(mr + 5 * DM) + F.lane + 64 * j), gg = *((const f32x4*)gpo + F.lane + 64 * j);
                orow[64 * j] = x[rr][j] + ga * (z[rr][j] * rstd * gg); } }
    }
}

constexpr int NPHASE = 11;
struct Args { const float* in[21]; float* out; unsigned char* ws; int ph_lo, ph_hi; };
__global__ void __launch_bounds__(NTHR, 2) fwd_mega(Args args) {
    extern __shared__ __attribute__((aligned(16))) unsigned char lds[];
    cg::grid_group grid = cg::this_grid();
    Frame F;
    F.lds = (LAS unsigned char*)lds;
    F.tid = threadIdx.x; F.lane = F.tid & 63; F.wave = __builtin_amdgcn_readfirstlane(F.tid >> 6);
    F.G = gridDim.x; { const int bx = blockIdx.x; F.vcu = (F.G % 8 == 0) ? (bx % 8) * (F.G / 8) + bx / 8 : bx; }
#pragma unroll
    for (int i = 0; i < 21; ++i) F.in[i] = args.in[i];
    F.out = args.out; F.ws = args.ws;
    unsigned char* ws = args.ws;
    const int lo = args.ph_lo, hi = args.ph_hi;
#define IN(k) (lo <= (k) && (k) < hi)
#define SEAM(k) do { if (IN(k) && IN((k) + 1)) grid.sync(); } while (0)
#define PH_BEGIN(k) if (IN(k)) _Pragma("unroll") for (int rep_ = 0; rep_ < ((DUP_PHASE == (k)) ? 2 : 1); ++rep_) { if (rep_) grid.sync();
#define PH_END(k) } SEAM(k);
    typedef pg8::bf16_t pb;
    PH_BEGIN(0) p0_prologue(F); PH_END(0)
    PH_BEGIN(1) p1_rows(F); PH_END(1)
    PH_BEGIN(2)
        pg8::Gemm g{(const pb*)(ws + WS_XN), (const pb*)(ws + WS_WIN), MALL, NIN, DM};
        pg8::InprojOrder S; S.init(F.G, (int)blockIdx.x);
        pg8::EpiInproj E{(pb*)(ws + WS_Q), (pb*)(ws + WS_K), (pb*)(ws + WS_V), (pb*)(ws + WS_PI), (pb*)(ws + WS_GT), F.in[12], F.in[13], F.in[11],
                         (const float*)(ws + WS_COS), (const float*)(ws + WS_SIN), (PG8_LAS float*)(F.lds + EXCH_OFF)};
        pg8::gemm_phase<pg8::EpiInproj, pg8::InprojOrder, true, true>(F.lds, g, S, E);
    PH_END(2)
    PH_BEGIN(3)
        const attn::bf16* Q = (const attn::bf16*)(ws + WS_Q); const attn::bf16* K = (const attn::bf16*)(ws + WS_K); const attn::bf16* V = (const attn::bf16*)(ws + WS_V); attn::bf16* AO = (attn::bf16*)(ws + WS_AO);
        for (int u = blockIdx.x; u < BATCH * 8 * 8; u += F.G) {
            const int pair = (u >> 8) * 8 + (u & 7), idx = (u & 255) >> 3, gq = idx >> 3, qb = idx & 7, b = pair >> 1, kvh = pair & 1, h = kvh * 4 + gq;
            const size_t qoff = ((size_t)b * SEQ + qb * 256) * 1024 + h * 128, koff = (size_t)b * pg8::KVROWS * 256 + kvh * 128;
            attn::attn_dense_body<attn::bf16>(Q + qoff, K + koff, V + koff, AO + qoff, pg8::KVROWS, (char*)lds);
            __syncthreads();
        }
        p3_pool(F);
    PH_END(3)
    PH_BEGIN(4)
        pg8::Gemm g{(const pb*)(ws + WS_PLD), (const pb*)(ws + WS_WGB), MLAT, 512, 512};
        pg8::StaticOrder S; S.init(MLAT, 512, F.G, (int)blockIdx.x);
        pg8::EpiGen<0> E{(pb*)(ws + WS_MIX), 512, F.in[16], nullptr, 0, nullptr};
        pg8::gemm_phase<pg8::EpiGen<0>, pg8::StaticOrder, true, true>(F.lds, g, S, E);
    PH_END(4)
    PH_BEGIN(5)
        { pg8::Gemm g{(const pb*)(ws + WS_MIX), (const pb*)(ws + WS_WPU), MLAT, DM, 512};
          pg8::StaticOrder S; S.init(MLAT, DM, F.G, (int)blockIdx.x);
          pg8::EpiGen<1> E{(pb*)(ws + WS_T), DM, nullptr, (const pb*)(ws + WS_GT), DM, nullptr};
          pg8::gemm_phase<pg8::EpiGen<1>, pg8::StaticOrder, true, true>(F.lds, g, S, E); }
        { pg8::Gemm g{(const pb*)(ws + WS_AO), (const pb*)(ws + WS_WAU), MLAT, DM, DM};
          pg8::StaticOrder S; S.init(MLAT, DM, F.G, (int)blockIdx.x);
          pg8::EpiGen<2> E{(pb*)(ws + WS_MB), DM, nullptr, (const pb*)(ws + WS_GT), 0, (const pb*)(ws + WS_T)};
          pg8::gemm_phase<pg8::EpiGen<2>, pg8::StaticOrder, true, true>(F.lds, g, S, E); }
    PH_END(5)
    PH_BEGIN(6)
        pg8::Gemm g{(const pb*)(ws + WS_MB), (const pb*)(ws + WS_WOUT), MLAT, DM, DM};
        pg8::StaticOrder S; S.init(MLAT, DM, F.G, (int)blockIdx.x);
        pg8::EpiF32 E{(float*)(ws + WS_Y), DM};
        pg8::gemm_phase<pg8::EpiF32, pg8::StaticOrder, true, true>(F.lds, g, S, E);
    PH_END(6)
    PH_BEGIN(7) p7_rows(F); PH_END(7)
    PH_BEGIN(8)
        pg8::Gemm g{(const pb*)(ws + WS_XN2), (const pb*)(ws + WS_WF1), MLAT, DFF, DM};
        pg8::StaticOrder S; S.init(MLAT, DFF, F.G, (int)blockIdx.x);
        pg8::EpiGen<3> E{(pb*)(ws + WS_F), DFF, nullptr, nullptr, 0, nullptr};
        pg8::gemm_phase<pg8::EpiGen<3>, pg8::StaticOrder, true, true>(F.lds, g, S, E);
    PH_END(8)
    PH_BEGIN(9)
        pg8::Gemm g{(const pb*)(ws + WS_F), (const pb*)(ws + WS_WF2), MLAT, DM, DFF};
        pg8::StaticOrder S; S.init(MLAT, DM, F.G, (int)blockIdx.x);
        pg8::EpiF32 E{(float*)(ws + WS_Z), DM};
        pg8::gemm_phase<pg8::EpiF32, pg8::StaticOrder, true, true>(F.lds, g, S, E);
    PH_END(9)
    if (IN(10)) { p10_rows(F); }
#undef IN
#undef SEAM
}

extern "C" void kernel_launch(void* const* d_in, const int* in_sizes, int n_in, void* d_out, int out_size, void* d_ws, size_t ws_size, hipStream_t stream) {
    static int grid = 0;
    if (grid == 0) {
        if (n_in != 21 || out_size != MLAT * DM || ws_size < WS_END) { fprintf(stderr, "kernel_launch: unexpected shapes: n_in %d out %d ws %zu (need %zu)\n", n_in, out_size, ws_size, (size_t)WS_END); grid = -1; return; }
        int dev = 0, cus = 0, per_cu = 0;
        if (hipGetDevice(&dev) != hipSuccess || hipDeviceGetAttribute(&cus, hipDeviceAttributeMultiprocessorCount, dev) != hipSuccess) { grid = -1; return; }
        if (hipFuncSetAttribute((const void*)fwd_mega, hipFuncAttributeMaxDynamicSharedMemorySize, LDS_BYTES) != hipSuccess) { fprintf(stderr, "kernel_launch: hipFuncSetAttribute failed\n"); grid = -1; return; }
        if (hipOccupancyMaxActiveBlocksPerMultiprocessor(&per_cu, (const void*)fwd_mega, NTHR, LDS_BYTES) != hipSuccess || per_cu < 1) per_cu = 1;
        (void)hipGetLastError();
        grid = cus * per_cu;
    }
    if (grid < 0) return;
    Args a{};
    for (int i = 0; i < 21; ++i) a.in[i] = (const float*)d_in[i];
    a.out = (float*)d_out; a.ws = (unsigned char*)d_ws;
#if MK_MULTI
    for (int p = 0; p < NPHASE; ++p) { a.ph_lo = p; a.ph_hi = p + 1; hipLaunchKernelGGL(fwd_mega, dim3(grid), dim3(NTHR), LDS_BYTES, stream, a); }
#else
    a.ph_lo = 0; a.ph_hi = NPHASE;
    void* kargs[] = {&a};
    const hipError_t e = hipLaunchCooperativeKernel((const void*)fwd_mega, dim3(grid), dim3(NTHR), kargs, LDS_BYTES, stream);
    if (e != hipSuccess) fprintf(stderr, "kernel_launch: cooperative launch failed: %s (grid %d)\n", hipGetErrorString(e), grid);
#endif
}
```
